# Optimizing an MI355X kernel written in HIP

```python
import math
import jax, jax.numpy as jnp
from jax import lax
import numpy as np

D_MODEL = 1024
BATCH = 16
SEQ = 4096
DEPTH = 1

MIX_WIDTH = D_MODEL
ATTN_HEAD_DIM = 64
ATTN_WIDTH = MIX_WIDTH // 2
ATTN_HEADS = ATTN_WIDTH // ATTN_HEAD_DIM
RWKV_HEAD_DIM = 64
RWKV_WIDTH = MIX_WIDTH - ATTN_WIDTH
RWKV_HEADS = RWKV_WIDTH // RWKV_HEAD_DIM
DILATED_PATTERNS = ((128, 1), (512, 4), (2048, 16))
ATTN_BLOCK = 128
DECAY_LORA = 64
ICLR_LORA = 64
GATE_LORA = 128
N_EXPERTS = 32
TOP_K = 4
D_FF = D_MODEL
SWIGLU_LIMIT = 7.0
SWIGLU_ALPHA = 1.702
MOE_BLOCK = 256
RMS_EPS = 1e-5
GN_EPS = 64e-5
SHIFT_WIDTH = 3 * RWKV_WIDTH + DECAY_LORA + ICLR_LORA + GATE_LORA
IN_WIDTH = 3 * ATTN_WIDTH + SHIFT_WIDTH

kernel_name = "hybrid_dilated_attn_rwkv7_moe"

F32 = jnp.float32


def rmsnorm(x, g):
    x32 = x.astype(F32)
    y = x32 * lax.rsqrt(jnp.mean(x32 * x32, axis=-1, keepdims=True) + RMS_EPS)
    return (y * g.astype(F32)).astype(x.dtype)


def token_shift(z):
    return jnp.pad(z[:, :-1], ((0, 0), (1, 0), (0, 0)))


def alibi_slopes(n_heads):
    return jnp.exp2(-8.0 / n_heads * jnp.arange(1, n_heads + 1, dtype=F32))


def dilated_window(q, k, v, slopes, window, dil):
    B, S, H, Dh = q.shape
    steps = window // dil
    C = ATTN_BLOCK
    n_sub = -(-S // dil)
    nb = -(-n_sub // C)
    Sp = nb * C * dil
    pad = ((0, 0), (0, Sp - S), (0, 0), (0, 0))

    def to_blocks(t):
        t = jnp.pad(t, pad).reshape(B, nb, C, dil, H, Dh)
        return t.transpose(0, 3, 4, 1, 2, 5)

    qb, kb, vb = to_blocks(q), to_blocks(k), to_blocks(v)
    shift = lambda t: jnp.pad(t[:, :, :, :-1], ((0, 0), (0, 0), (0, 0), (1, 0), (0, 0), (0, 0)))
    kk = jnp.concatenate([shift(kb), kb], axis=4)
    vv = jnp.concatenate([shift(vb), vb], axis=4)

    scale = 1.0 / math.sqrt(Dh)
    s = jnp.einsum('brhnqe,brhnke->brhnqk', qb, kk, preferred_element_type=F32) * scale
    diff = (jnp.arange(C)[:, None] + C) - jnp.arange(2 * C)[None, :]
    band = (diff >= 0) & (diff <= steps)
    first_ok = (jnp.arange(nb)[:, None, None] > 0) | (jnp.arange(2 * C)[None, None, :] >= C)
    valid = band[None] & first_ok
    bias = -slopes[:, None, None] * (dil * diff).astype(F32)[None]
    s = s + bias[None, None, :, None]
    s = jnp.where(valid[None, None, None], s, -jnp.inf)
    m = jnp.max(s, axis=-1, keepdims=True)
    p = jnp.exp(s - m)
    den = jnp.sum(p, axis=-1, keepdims=True)
    o = jnp.einsum('brhnqk,brhnke->brhnqe', p, vv.astype(F32)) / den
    lse = (m + jnp.log(den))[..., 0]
    o = o.transpose(0, 3, 4, 1, 2, 5).reshape(B, Sp, H, Dh)[:, :S]
    lse = lse.transpose(0, 3, 4, 1, 2).reshape(B, Sp, H)[:, :S]
    return o, lse


def dilated_attention(q, k, v):
    slopes = alibi_slopes(q.shape[2])
    outs, lses = [], []
    for window, dil in DILATED_PATTERNS:
        o, l = dilated_window(q, k, v, slopes, window, dil)
        outs.append(o)
        lses.append(l)
    wts = jax.nn.softmax(jnp.stack(lses, 0), axis=0)
    return jnp.sum(wts[..., None] * jnp.stack(outs, 0), axis=0)


def rwkv7_mix(r, k, v, wd, ad, gd, decay_w0, w_decay_up, iclr_a0, w_iclr_up, w_gate_lr_up,
              k_k, k_a, r_k, gn_w, gn_b):
    B, S, W = r.shape
    H, N = RWKV_HEADS, RWKV_HEAD_DIM
    w = -jax.nn.softplus(-(decay_w0 + jnp.tanh(wd) @ w_decay_up)) - 0.5
    decay = jnp.exp(-jnp.exp(w))
    a = jax.nn.sigmoid(iclr_a0 + ad @ w_iclr_up)
    g = jax.nn.sigmoid(gd) @ w_gate_lr_up
    heads = lambda t: t.reshape(B, S, H, N)
    kk = heads(k * k_k)
    kk = kk / jnp.maximum(jnp.sqrt(jnp.sum(kk * kk, -1, keepdims=True)), 1e-12)
    k = k * (1.0 + (a - 1.0) * k_a)
    rh, wh, kh, vh, ah = heads(r), heads(decay), heads(k), heads(v), heads(a)

    def step(state, inp):
        r_t, w_t, k_t, v_t, kk_t, a_t = inp
        sa = jnp.einsum('bhij,bhj->bhi', state, kk_t)
        state = (state * w_t[:, :, None, :]
                 - sa[..., None] * (kk_t * a_t)[:, :, None, :]
                 + v_t[..., None] * k_t[:, :, None, :])
        return state, jnp.einsum('bhij,bhj->bhi', state, r_t)

    xs = tuple(jnp.moveaxis(t, 1, 0) for t in (rh, wh, kh, vh, kk, ah))
    state0 = jnp.zeros((B, H, N, N), F32)
    _, ys = lax.scan(step, state0, xs)
    y = jnp.moveaxis(ys, 0, 1)
    mu = jnp.mean(y, -1, keepdims=True)
    var = jnp.mean(jnp.square(y - mu), -1, keepdims=True)
    yn = ((y - mu) * lax.rsqrt(var + GN_EPS)).reshape(B, S, W) * gn_w + gn_b
    bonus = (jnp.sum(rh * kh * r_k, -1, keepdims=True) * vh).reshape(B, S, W)
    return (yn + bonus) * g


def moe_ffn(xn, w_router, b_router, w_gate_up, b_gate_up, w_down, b_down):
    Bsz, S, D = xn.shape
    n_tok = Bsz * S
    xf = xn.reshape(n_tok, D)
    logits = jnp.matmul(xf, w_router, preferred_element_type=F32) + b_router.astype(F32)
    top_val, top_idx = lax.top_k(logits, TOP_K)
    gates = jax.nn.softmax(top_val, axis=-1)
    n_assign = n_tok * TOP_K
    e_flat = top_idx.reshape(n_assign).astype(jnp.int32)
    g_flat = gates.reshape(n_assign)
    t_flat = jnp.repeat(jnp.arange(n_tok, dtype=jnp.int32), TOP_K)
    order = jnp.argsort(e_flat)
    e_s, t_s, g_s = e_flat[order], t_flat[order], g_flat[order]
    counts = jnp.bincount(e_flat, length=N_EXPERTS)
    padded = (counts + MOE_BLOCK - 1) // MOE_BLOCK * MOE_BLOCK
    start = jnp.cumsum(counts) - counts
    pend = jnp.cumsum(padded)
    pstart = pend - padded
    dest = pstart[e_s] + (jnp.arange(n_assign, dtype=jnp.int32) - start[e_s])
    n_blocks = (n_assign + N_EXPERTS * (MOE_BLOCK - 1) + MOE_BLOCK - 1) // MOE_BLOCK
    n_rows = n_blocks * MOE_BLOCK
    row_tok = jnp.full((n_rows,), n_tok, jnp.int32).at[dest].set(t_s)
    row_gate = jnp.zeros((n_rows,), F32).at[dest].set(g_s)
    blk_expert = jnp.minimum(
        jnp.searchsorted(pend, jnp.arange(n_blocks, dtype=pend.dtype) * MOE_BLOCK, side='right'),
        N_EXPERTS - 1)
    xpad = jnp.concatenate([xf, jnp.zeros((1, D), xf.dtype)], axis=0)

    def expert_block(args):
        tok, gate, e = args
        hb = xpad[tok]
        gu = hb @ w_gate_up[e] + b_gate_up[e]
        g_lin = jnp.minimum(gu[:, :D_FF], SWIGLU_LIMIT)
        u_lin = jnp.clip(gu[:, D_FF:], -SWIGLU_LIMIT, SWIGLU_LIMIT)
        act = (u_lin + 1.0) * (g_lin * jax.nn.sigmoid(SWIGLU_ALPHA * g_lin))
        out = act @ w_down[e] + b_down[e]
        return out.astype(F32) * gate[:, None]

    outs = lax.map(expert_block, (row_tok.reshape(n_blocks, MOE_BLOCK),
                                  row_gate.reshape(n_blocks, MOE_BLOCK), blk_expert))
    y = jnp.zeros((n_tok + 1, D), F32).at[row_tok].add(outs.reshape(n_rows, D))
    return y[:n_tok].reshape(Bsz, S, D).astype(xn.dtype)


def setup_inputs(seed: int = 0) -> dict:
    key = jax.random.key(seed)
    ks = jax.random.split(key, 24)
    L = DEPTH
    nrm = lambda k, shape, scale: jax.random.normal(k, shape, F32) * scale
    return {
        "x": nrm(ks[0], (BATCH, SEQ, D_MODEL), 1.0),
        "norm_mix_g": 1.0 + nrm(ks[1], (L, D_MODEL), 0.02),
        "w_in": nrm(ks[2], (L, D_MODEL, IN_WIDTH), D_MODEL ** -0.5),
        "shift_mu": jax.random.uniform(ks[3], (L, SHIFT_WIDTH), F32, 0.2, 0.8),
        "decay_w0": -0.6 + nrm(ks[4], (L, RWKV_WIDTH), 0.3),
        "w_decay_up": nrm(ks[5], (L, DECAY_LORA, RWKV_WIDTH), 0.1),
        "iclr_a0": nrm(ks[6], (L, RWKV_WIDTH), 0.1),
        "w_iclr_up": nrm(ks[7], (L, ICLR_LORA, RWKV_WIDTH), 0.1),
        "w_gate_lr_up": nrm(ks[8], (L, GATE_LORA, RWKV_WIDTH), GATE_LORA ** -0.5),
        "k_k": 0.85 + nrm(ks[9], (L, RWKV_WIDTH), 0.02),
        "k_a": 1.0 + nrm(ks[10], (L, RWKV_WIDTH), 0.02),
        "r_k": nrm(ks[11], (L, RWKV_HEADS, RWKV_HEAD_DIM), 0.1),
        "gn_w": 1.0 + nrm(ks[12], (L, RWKV_WIDTH), 0.02),
        "gn_b": nrm(ks[13], (L, RWKV_WIDTH), 0.01),
        "w_out": nrm(ks[14], (L, MIX_WIDTH, D_MODEL), MIX_WIDTH ** -0.5),
        "norm_ffn_g": 1.0 + nrm(ks[15], (L, D_MODEL), 0.02),
        "w_router": nrm(ks[16], (L, D_MODEL, N_EXPERTS), D_MODEL ** -0.5),
        "b_router": nrm(ks[17], (L, N_EXPERTS), 0.01),
        "w_gate_up": nrm(ks[18], (L, N_EXPERTS, D_MODEL, 2 * D_FF), D_MODEL ** -0.5),
        "b_gate_up": nrm(ks[19], (L, N_EXPERTS, 2 * D_FF), 0.01),
        "w_down": nrm(ks[20], (L, N_EXPERTS, D_FF, D_MODEL), D_FF ** -0.5),
        "b_down": nrm(ks[21], (L, N_EXPERTS, D_MODEL), 0.01),
        "norm_final_g": 1.0 + nrm(ks[22], (D_MODEL,), 0.02),
    }


def reference(x, norm_mix_g, w_in, shift_mu, decay_w0, w_decay_up, iclr_a0, w_iclr_up,
              w_gate_lr_up, k_k, k_a, r_k, gn_w, gn_b, w_out, norm_ffn_g, w_router, b_router,
              w_gate_up, b_gate_up, w_down, b_down, norm_final_g):
    B, S, _ = x.shape
    h = x
    for l in range(DEPTH):
        xn = rmsnorm(h, norm_mix_g[l])
        proj = xn @ w_in[l]
        qa, ka, va = jnp.split(proj[..., :3 * ATTN_WIDTH], 3, axis=-1)
        rest = proj[..., 3 * ATTN_WIDTH:].astype(F32)
        rest = rest + (token_shift(rest) - rest) * shift_mu[l]
        o1 = RWKV_WIDTH
        r_, k_, v_ = rest[..., :o1], rest[..., o1:2 * o1], rest[..., 2 * o1:3 * o1]
        wd = rest[..., 3 * o1:3 * o1 + DECAY_LORA]
        ad = rest[..., 3 * o1 + DECAY_LORA:3 * o1 + DECAY_LORA + ICLR_LORA]
        gd = rest[..., 3 * o1 + DECAY_LORA + ICLR_LORA:]

        hd = lambda t: t.reshape(B, S, ATTN_HEADS, ATTN_HEAD_DIM)
        attn = dilated_attention(hd(qa), hd(ka), hd(va)).reshape(B, S, ATTN_WIDTH)
        rw = rwkv7_mix(r_, k_, v_, wd, ad, gd,
                       decay_w0[l].astype(F32), w_decay_up[l].astype(F32), iclr_a0[l].astype(F32),
                       w_iclr_up[l].astype(F32), w_gate_lr_up[l].astype(F32), k_k[l].astype(F32),
                       k_a[l].astype(F32), r_k[l].astype(F32), gn_w[l].astype(F32), gn_b[l].astype(F32))
        mixed = jnp.concatenate([attn.astype(h.dtype), rw.astype(h.dtype)], axis=-1) @ w_out[l]
        h = h + mixed
        h = h + moe_ffn(rmsnorm(h, norm_ffn_g[l]), w_router[l], b_router[l], w_gate_up[l],
                        b_gate_up[l], w_down[l], b_down[l])
    return rmsnorm(h, norm_final_g)
```

```cpp
#include <hip/hip_runtime.h>
#include <hip/hip_cooperative_groups.h>
#include <cstdio>
#include <cstdint>
namespace cg = cooperative_groups;

#ifndef MOE_FP8_GU
#define MOE_FP8_GU 1
#endif
#ifndef MOE_FP8_DN
#define MOE_FP8_DN 1
#endif
#ifndef EOUT_FP8
#define EOUT_FP8 1
#endif
#ifndef RWKV_CHUNKED
#define RWKV_CHUNKED 1
#endif
#if RWKV_CHUNKED
#define RWKV_FN rwkv_head_chunked
#else
#define RWKV_FN rwkv_head
#endif
#ifndef USE_CG_SYNC
#define USE_CG_SYNC 0
#endif
#ifndef MK_MULTI
#define MK_MULTI 0
#endif

#define LAS __attribute__((address_space(3)))
typedef unsigned short bf16_t;
typedef short bf16x8 __attribute__((ext_vector_type(8)));
typedef short s16x4 __attribute__((ext_vector_type(4)));
typedef float f32x2 __attribute__((ext_vector_type(2)));
typedef float f32x4 __attribute__((ext_vector_type(4)));
typedef float f32x16 __attribute__((ext_vector_type(16)));
typedef unsigned u32x4 __attribute__((ext_vector_type(4)));
typedef unsigned u32x2 __attribute__((ext_vector_type(2)));
typedef int i32x4 __attribute__((ext_vector_type(4)));
typedef int i32x8 __attribute__((ext_vector_type(8)));

constexpr int NB = 16, SEQ = 4096, DM = 1024, MTOK = NB * SEQ;
constexpr int INW = 3328, NH = 8, HD = 64;
constexpr int NE = 32, DFF = 1024;
#ifndef MOE_NSLAB
#define MOE_NSLAB 1
#endif
constexpr int NSLAB = MOE_NSLAB, SLABT = MTOK / NSLAB;
constexpr int LCAP = SLABT;
constexpr int ACT_ROWS = SLABT * 4 + NE * 256;
constexpr int NWAVES = 8, NTHR = 512;
constexpr int LDS_BYTES = 163840;
constexpr int GEMM_LDS = 131072, MISC_OFF = 131072, XBST_OFF = LDS_BYTES - 64;

constexpr size_t MiB = 1u << 20;
constexpr size_t WS_CTL = 0, CTL_BYTES = 64 * 1024;
constexpr size_t WS_WIN = 1 * MiB, WS_WOUT = 8 * MiB, WS_WGU = 10 * MiB, WS_WDN = 138 * MiB;
constexpr size_t WS_LIST = 202 * MiB, WS_GLIST = 210 * MiB, WS_LSE = 218 * MiB;
constexpr size_t WS_XN = 224 * MiB, WS_PROJ = 352 * MiB, WS_MIX = 768 * MiB, WS_END = 896 * MiB;
constexpr size_t WS_XN2 = (NSLAB == 1) ? 74 * MiB : WS_XN;
constexpr size_t WS_ACT = (NSLAB == 1) ? 224 * MiB : 352 * MiB, WS_EOUT = (NSLAB == 1) ? 488 * MiB : 624 * MiB;
constexpr size_t WS_NEED = (NSLAB == 1) ? 1016 * MiB : WS_END;
static_assert(WS_ACT + (size_t)ACT_ROWS * DFF * (MOE_FP8_DN ? 1 : 2) <= WS_EOUT && WS_EOUT + (size_t)ACT_ROWS * DM * 2 <= WS_NEED && (NSLAB != 1 || (MOE_FP8_GU && MOE_FP8_DN)), "ws map");
constexpr int CW_CNT = 1024, CW_BAR = 4096, CW_SUB = 8192;

struct Args { const float* in[23]; float* out; unsigned char* ws; int ph_lo, ph_hi; };
enum { I_X = 0, I_GMIX, I_WIN, I_MU, I_W0, I_WDU, I_A0, I_WIU, I_WGU, I_KK, I_KA, I_RK, I_GNW, I_GNB, I_WOUT, I_GFFN, I_WR, I_BR, I_WGUP, I_BGUP, I_WDN, I_BDN, I_GFIN };

typedef __bf16 bf16x2_t __attribute__((ext_vector_type(2)));
__device__ __forceinline__ unsigned pk2(float lo, float hi) { f32x2 v = {lo, hi}; bf16x2_t b = __builtin_convertvector(v, bf16x2_t); return __builtin_bit_cast(unsigned, b); }
__device__ __forceinline__ unsigned f2bf(float f) { return pk2(f, f) & 0xffffu; }
__device__ __forceinline__ float bf2f(unsigned short b) { return __builtin_bit_cast(float, (unsigned)b << 16); }
__device__ __forceinline__ float bflo(unsigned w) { return __builtin_bit_cast(float, w << 16); }
__device__ __forceinline__ float bfhi(unsigned w) { return __builtin_bit_cast(float, w & 0xffff0000u); }
template <int CTRL> __device__ __forceinline__ float dpp_f(float v) { return __builtin_bit_cast(float, __builtin_amdgcn_update_dpp(0, __builtin_bit_cast(int, v), CTRL, 0xF, 0xF, true)); }
__device__ __forceinline__ float sum8(float v) { v += dpp_f<0xB1>(v); v += dpp_f<0x4E>(v); v += dpp_f<0x141>(v); return v; }
template <int CTRL, int RMASK> __device__ __forceinline__ float dpp_rm(float v) { return __builtin_bit_cast(float, __builtin_amdgcn_update_dpp(0, __builtin_bit_cast(int, v), CTRL, RMASK, 0xF, false)); }
__device__ __forceinline__ float scan64(float v) {
    v += dpp_f<0x111>(v); v += dpp_f<0x112>(v); v += dpp_f<0x114>(v); v += dpp_f<0x118>(v);
    v += dpp_rm<0x142, 0xA>(v); v += dpp_rm<0x143, 0xC>(v);
    return v;
}
__device__ __forceinline__ float sum16(float v) { v = sum8(v); v += dpp_f<0x140>(v); return v; }
__device__ __forceinline__ float wave_sum(float v) {
    v = sum16(v);
    const float a = __builtin_bit_cast(float, __builtin_amdgcn_readlane(__builtin_bit_cast(int, v), 0)), b = __builtin_bit_cast(float, __builtin_amdgcn_readlane(__builtin_bit_cast(int, v), 16));
    const float c = __builtin_bit_cast(float, __builtin_amdgcn_readlane(__builtin_bit_cast(int, v), 32)), d = __builtin_bit_cast(float, __builtin_amdgcn_readlane(__builtin_bit_cast(int, v), 48));
    return (a + b) + (c + d);
}
__device__ __forceinline__ float sigmoidf_(float x) { return 1.0f / (1.0f + __expf(-x)); }
__device__ __forceinline__ unsigned pk4_fp8(float a, float b, float c, float d) { int w = 0; w = __builtin_amdgcn_cvt_pk_fp8_f32(a, b, w, false); w = __builtin_amdgcn_cvt_pk_fp8_f32(c, d, w, true); return (unsigned)w; }
#define LDS_WAIT() asm volatile("s_waitcnt lgkmcnt(0)" ::: "memory")

namespace pg8 {
constexpr int BM = 256, BK = 64, HALF = 128, HTB = HALF * BK * 2, NXCD = 8, WGM = 4;
__device__ __forceinline__ int lds_byte(int r, int c) { const int st = (r >> 4) * 2 + (c >> 5), rr = r & 15, cc = c & 31, ob = rr * 64 + cc * 2; return st * 1024 + (ob ^ (((ob >> 9) & 1) << 5)); }
__device__ __forceinline__ void stage_rc(int b, int& R, int& C) { const int st = b / 1024, sb = b % 1024, swz = sb ^ (((sb >> 9) & 1) << 5); R = (st >> 1) * 16 + swz / 64; C = (st & 1) * 32 + (swz % 64) / 2; }
__device__ __forceinline__ int perm32(int rho) { const int n = rho >> 4, i = rho & 15; return 8 * (i >> 2) + 4 * n + (i & 3); }

struct Unit { int pm, pn, e, cnt, rbase; };

struct DenseOrder {
    int nM, nN, nwg, G, c;
    __device__ void init(int M, int N, int G_, int c_) { nM = M / BM; nN = N / BM; nwg = nM * nN; G = G_; c = c_; }
    __device__ bool next(int i, Unit& u) const {
        const long L = (long)i * G + c; if (L >= nwg) return false;
        int wgid = (int)L; { const int q = nwg / NXCD, r = nwg % NXCD, xcd = wgid % NXCD, off = wgid / NXCD; wgid = (xcd < r ? xcd * (q + 1) : r * (q + 1) + (xcd - r) * q) + off; }
        const int nig = WGM * nN, gid = wgid / nig, fm = gid * WGM, gsz = (nM - fm) < WGM ? (nM - fm) : WGM;
        u.pm = fm + ((wgid % nig) % gsz); u.pn = (wgid % nig) / gsz; u.e = 0; u.cnt = 0; u.rbase = 0; return true;
    }
};

__device__ __forceinline__ unsigned cvt_pk_bf16(float lo, float hi) { unsigned r; asm volatile("v_cvt_pk_bf16_f32 %0, %1, %2" : "=v"(r) : "v"(lo), "v"(hi)); return r; }

template <class Epi, class Sched, bool FP8 = false>
__device__ __forceinline__ void gemm_phase(LAS unsigned char* lds, const bf16_t* A, const bf16_t* Bt, const int K, const Sched& S, const Epi& E) {
    int tid = threadIdx.x; asm volatile("" : "+v"(tid));
    const int wid = __builtin_amdgcn_readfirstlane(tid >> 6), lane = tid & 63, wr = wid >> 2, wc = wid & 3, fr = lane & 15, fq = lane >> 4;
    const int nt = K / BK;
    unsigned voffB[2];
#pragma unroll
    for (int i = 0; i < 2; ++i) { int R, C; stage_rc(tid * 16 + i * 8192, R, C); const int Rb = Epi::PERM ? ((R & ~31) + perm32(R & 31)) : R; voffB[i] = (unsigned)(Rb * K + C) * 2u; }
#define PG8_RC(i_) int t2_ = tid; asm volatile("" : "+v"(t2_)); int R_, C_; stage_rc(t2_ * 16 + (i_) * 8192, R_, C_)
    const size_t kstep = (size_t)(BK * 2);
    const size_t hstep = (size_t)HALF * K * 2;
    const unsigned ldsw = (unsigned)wid * 1024u;
    const int aoff = lds_byte(wr * 64 + fr, fq * 8), boff = lds_byte(wc * 32 + fr, fq * 8);
#define PG8_SA(b, h) (((b) * 2 + (h)) * HTB)
#define PG8_SB(b, h) ((4 + (b) * 2 + (h)) * HTB)
#define PG8_STAGE(bufoff, gbase, voff) do { _Pragma("unroll") for (int _i = 0; _i < 2; ++_i) \
        __builtin_amdgcn_global_load_lds((const unsigned*)((const char*)(gbase) + (voff)[_i]), (LAS unsigned*)(lds + (bufoff) + ldsw + _i * 8192), 16, 0, 0); } while (0)
#define PG8_LDA(dst, b, h) do { _Pragma("unroll") for (int m = 0; m < 4; ++m) _Pragma("unroll") for (int k = 0; k < 2; ++k) dst[m][k] = *(const LAS bf16x8*)(lds + PG8_SA(b, h) + aoff + m * 2048 + k * 1024); } while (0)
#define PG8_LDB(dst, b, h) do { _Pragma("unroll") for (int n = 0; n < 2; ++n) _Pragma("unroll") for (int k = 0; k < 2; ++k) dst[n][k] = *(const LAS bf16x8*)(lds + PG8_SB(b, h) + boff + n * 2048 + k * 1024); } while (0)
#define PG8_MMA(ai, bj, At, Bt_) do { __builtin_amdgcn_s_setprio(1); \
        if constexpr (FP8) { _Pragma("unroll") for (int m = 0; m < 4; ++m) _Pragma("unroll") for (int n = 0; n < 2; ++n) { \
            const i32x8 bw_ = __builtin_shufflevector(__builtin_bit_cast(i32x4, Bt_[n][0]), __builtin_bit_cast(i32x4, Bt_[n][1]), 0, 1, 2, 3, 4, 5, 6, 7); \
            const i32x8 aw_ = __builtin_shufflevector(__builtin_bit_cast(i32x4, At[m][0]), __builtin_bit_cast(i32x4, At[m][1]), 0, 1, 2, 3, 4, 5, 6, 7); \
            asm volatile("v_mfma_scale_f32_16x16x128_f8f6f4 %0, %1, %2, %0, %3, %4 op_sel_hi:[0,0,0]" : "+v"(acc[ai][bj][m][n]) : "v"(bw_), "v"(aw_), "v"(sc_w8), "v"(sc_a8)); } } \
        else { _Pragma("unroll") for (int m = 0; m < 4; ++m) _Pragma("unroll") for (int n = 0; n < 2; ++n) _Pragma("unroll") for (int k = 0; k < 2; ++k) \
            acc[ai][bj][m][n] = __builtin_amdgcn_mfma_f32_16x16x32_bf16(Bt_[n][k], At[m][k], acc[ai][bj][m][n], 0, 0, 0); } \
        __builtin_amdgcn_s_setprio(0); } while (0)
#define PG8_WAIT_V(n) asm volatile("s_waitcnt vmcnt(" #n ")" ::: "memory")
#define PG8_WAIT_L(n) asm volatile("s_waitcnt lgkmcnt(" #n ")" ::: "memory")
#define PG8_BAR __builtin_amdgcn_s_barrier()
#define PG8_SCHED __builtin_amdgcn_sched_barrier(0)
    Unit cur, nxt; int ui = 0;
    if (!S.next(0, cur)) return;
    f32x4 acc[2][2][4][2];
#pragma unroll
    for (int a = 0; a < 2; ++a)
#pragma unroll
        for (int b = 0; b < 2; ++b)
#pragma unroll
            for (int m = 0; m < 4; ++m)
#pragma unroll
                for (int n = 0; n < 2; ++n) acc[a][b][m][n] = (f32x4){0.f, 0.f, 0.f, 0.f};
    bf16x8 At[4][2], B0[2][2], B1[2][2];
    int sc_w8 = 0x7A7A7A7A, sc_a8 = 0x7F7F7F7F;
    asm volatile("" : "+v"(sc_w8), "+v"(sc_a8));
    unsigned cvA0[2], cvA1[2], nvA0[2], nvA1[2];
#pragma unroll
    for (int i = 0; i < 2; ++i) { PG8_RC(i); cvA0[i] = (S.a_row(cur, R_) * (unsigned)K + (unsigned)C_) * 2u; cvA1[i] = (S.a_row(cur, HALF + R_) * (unsigned)K + (unsigned)C_) * 2u; }
    const char* A8 = (const char*)A;
    const char* cB = (const char*)Bt + S.b_off(cur);
    PG8_STAGE(PG8_SB(0, 0), cB, voffB); PG8_STAGE(PG8_SB(0, 1), cB + hstep, voffB); PG8_STAGE(PG8_SA(0, 0), A8, cvA0); PG8_STAGE(PG8_SA(0, 1), A8, cvA1);
    if (wr == 1) PG8_BAR;
    PG8_WAIT_V(2); PG8_BAR;
    PG8_STAGE(PG8_SB(1, 0), cB + kstep, voffB); PG8_STAGE(PG8_SA(1, 0), A8 + kstep, cvA0); PG8_STAGE(PG8_SB(1, 1), cB + hstep + kstep, voffB);
    PG8_WAIT_V(6); PG8_BAR;
    for (;;) {
        const bool has_next = S.next(ui + 1, nxt);
        const char* nB = has_next ? (const char*)Bt + S.b_off(nxt) : cB;
        if (has_next) {
#pragma unroll
            for (int i = 0; i < 2; ++i) { PG8_RC(i); nvA0[i] = (S.a_row(nxt, R_) * (unsigned)K + (unsigned)C_) * 2u; nvA1[i] = (S.a_row(nxt, HALF + R_) * (unsigned)K + (unsigned)C_) * 2u; }
        } else {
#pragma unroll
            for (int i = 0; i < 2; ++i) { nvA0[i] = cvA0[i]; nvA1[i] = cvA1[i]; }
        }
        for (int t = 0; t < nt; t += 2) {
            const bool last = (t == nt - 2);
            const char* a1 = A8 + (size_t)(t + 1) * kstep;
            const char* a2 = last ? A8 : A8 + (size_t)(t + 2) * kstep; const char* b2 = last ? nB : cB + (size_t)(t + 2) * kstep;
            const char* a3 = a2 + kstep; const char* b3 = b2 + kstep;
            unsigned xA0[2], xA1[2];
#pragma unroll
            for (int i = 0; i < 2; ++i) { xA0[i] = last ? nvA0[i] : cvA0[i]; xA1[i] = last ? nvA1[i] : cvA1[i]; }
            PG8_LDB(B0, 0, 0); PG8_LDB(B1, 0, 1); PG8_SCHED; PG8_LDA(At, 0, 0); PG8_STAGE(PG8_SA(1, 1), a1, cvA1);
            PG8_WAIT_V(8); PG8_WAIT_L(0); PG8_BAR; PG8_MMA(0, 0, At, B0); PG8_MMA(0, 1, At, B1); PG8_BAR; PG8_SCHED;
            PG8_LDA(At, 0, 1); PG8_STAGE(PG8_SB(0, 0), b2, voffB); PG8_STAGE(PG8_SB(0, 1), b2 + hstep, voffB); PG8_STAGE(PG8_SA(0, 0), a2, xA0);
            PG8_WAIT_V(8); PG8_WAIT_L(0); PG8_BAR; PG8_MMA(1, 0, At, B0); PG8_MMA(1, 1, At, B1); PG8_BAR; PG8_SCHED;
            PG8_LDB(B0, 1, 0); PG8_LDB(B1, 1, 1); PG8_SCHED; PG8_LDA(At, 1, 0); PG8_STAGE(PG8_SA(0, 1), a2, xA1);
            PG8_WAIT_V(8); PG8_WAIT_L(0); PG8_BAR; PG8_MMA(0, 0, At, B0); PG8_MMA(0, 1, At, B1); PG8_BAR; PG8_SCHED;
            PG8_LDA(At, 1, 1); PG8_STAGE(PG8_SB(1, 0), b3, voffB); PG8_STAGE(PG8_SB(1, 1), b3 + hstep, voffB); PG8_STAGE(PG8_SA(1, 0), a3, xA0);
            PG8_WAIT_V(8); PG8_WAIT_L(0); PG8_BAR; PG8_MMA(1, 0, At, B0); PG8_MMA(1, 1, At, B1); PG8_BAR; PG8_SCHED;
        }
        if (wr == 0) PG8_BAR;
        E(acc, cur, wr, wc, fr, fq);
        if (!has_next) break;
#pragma unroll
        for (int a = 0; a < 2; ++a)
#pragma unroll
            for (int b = 0; b < 2; ++b)
#pragma unroll
                for (int m = 0; m < 4; ++m)
#pragma unroll
                    for (int n = 0; n < 2; ++n) acc[a][b][m][n] = (f32x4){0.f, 0.f, 0.f, 0.f};
        cur = nxt; cB = nB; ++ui;
#pragma unroll
        for (int i = 0; i < 2; ++i) { cvA0[i] = nvA0[i]; cvA1[i] = nvA1[i]; }
        if (wr == 1) PG8_BAR;
    }
    PG8_WAIT_V(0);
    PG8_BAR;
#undef PG8_RC
#undef PG8_SA
#undef PG8_SB
#undef PG8_STAGE
#undef PG8_LDA
#undef PG8_LDB
#undef PG8_MMA
#undef PG8_WAIT_V
#undef PG8_WAIT_L
#undef PG8_BAR
#undef PG8_SCHED
}
}

struct DenseSched {
    pg8::DenseOrder o;
    __device__ __forceinline__ bool next(int i, pg8::Unit& u) const { return o.next(i, u); }
    __device__ __forceinline__ size_t b_off(const pg8::Unit& u) const { return (size_t)u.pn * 256 * DM * 2; }
    __device__ __forceinline__ unsigned a_row(const pg8::Unit& u, int r) const { return (unsigned)(u.pm * 256 + r); }
};
struct MoeSched {
    const LAS int* tab;
    int nNt, G, vc; const unsigned* list; unsigned tokbase; int gather; size_t estride, tstride;
    __device__ __forceinline__ bool next(int i, pg8::Unit& u) const {
        const int L = i * G + vc; const int total = tab[32]; if (L >= total) return false;
        int e = 0;
#pragma unroll 1
        for (int s = 16; s >= 1; s >>= 1) if (tab[e + s] <= L) e += s;
        const int loc = L - tab[e]; u.e = e; u.pm = loc / nNt; u.pn = loc % nNt; u.cnt = tab[64 + e]; u.rbase = tab[128 + e]; return true;
    }
    __device__ __forceinline__ size_t b_off(const pg8::Unit& u) const { return (size_t)u.e * estride + (size_t)u.pn * tstride; }
    __device__ __forceinline__ unsigned a_row(const pg8::Unit& u, int r) const {
        const int pos = u.pm * 256 + r;
        if (gather) { unsigned ent = 0; if (pos < u.cnt) ent = list[(size_t)u.e * LCAP + pos]; return tokbase + (ent >> 2); }
        return (unsigned)(u.rbase + pos);
    }
};

struct EpiProj {
    static constexpr bool PERM = true; bf16_t* O;
    __device__ __forceinline__ void operator()(const f32x4 (&acc)[2][2][4][2], const pg8::Unit& u, int wr, int wc, int fr, int fq) const {
        const int row0 = u.pm * 256 + wr * 64 + fr, col0 = u.pn * 256 + wc * 32 + 8 * fq;
#pragma unroll
        for (int ai = 0; ai < 2; ++ai)
#pragma unroll
            for (int m = 0; m < 4; ++m) { bf16_t* rowp = O + (size_t)(row0 + ai * 128 + m * 16) * INW + col0;
#pragma unroll
                for (int bj = 0; bj < 2; ++bj) { const f32x4 v0 = acc[ai][bj][m][0], v1 = acc[ai][bj][m][1]; u32x4 w;
                    w.x = pg8::cvt_pk_bf16(v0[0], v0[1]); w.y = pg8::cvt_pk_bf16(v0[2], v0[3]); w.z = pg8::cvt_pk_bf16(v1[0], v1[1]); w.w = pg8::cvt_pk_bf16(v1[2], v1[3]);
                    *(u32x4*)(rowp + bj * 128) = w; } }
    }
};
struct EpiResid {
    static constexpr bool PERM = false; const float* X; float* H;
    __device__ __forceinline__ void operator()(const f32x4 (&acc)[2][2][4][2], const pg8::Unit& u, int wr, int wc, int fr, int fq) const {
        const int row0 = u.pm * 256 + wr * 64 + fr, col0 = u.pn * 256 + wc * 32 + 4 * fq;
#pragma unroll
        for (int ai = 0; ai < 2; ++ai)
#pragma unroll
            for (int m = 0; m < 4; ++m) { const size_t off = (size_t)(row0 + ai * 128 + m * 16) * DM + col0;
#pragma unroll
                for (int bj = 0; bj < 2; ++bj)
#pragma unroll
                    for (int n = 0; n < 2; ++n) { const f32x4 xv = *(const f32x4*)(X + off + bj * 128 + n * 16); *(f32x4*)(H + off + bj * 128 + n * 16) = xv + acc[ai][bj][m][n]; } }
    }
};
struct EpiSwiglu {
    static constexpr bool PERM = true; bf16_t* ACT; const float* bgu; int dry;
    __device__ __forceinline__ void operator()(const f32x4 (&acc)[2][2][4][2], const pg8::Unit& u, int wr, int wc, int fr, int fq) const {
        if (dry & 1) return;
        const int f0 = u.pn * 128 + wc * 32 + 8 * fq; const float* bb = bgu + (size_t)u.e * 2 * DFF;
        f32x4 bg[2], bu[2];
#pragma unroll
        for (int n = 0; n < 2; ++n) { bg[n] = *(const f32x4*)(bb + f0 + 4 * n); bu[n] = *(const f32x4*)(bb + DFF + f0 + 4 * n); }
#pragma unroll
        for (int ai = 0; ai < 2; ++ai)
#pragma unroll
            for (int m = 0; m < 4; ++m) { const int pos = u.pm * 256 + ai * 128 + wr * 64 + m * 16 + fr;
                float a[8];
#pragma unroll
                for (int n = 0; n < 2; ++n) { const f32x4 g = acc[ai][0][m][n] + bg[n], up = acc[ai][1][m][n] + bu[n];
#pragma unroll
                    for (int x = 0; x < 4; ++x) { const float gl = fminf(g[x], 7.0f), ul = fminf(fmaxf(up[x], -7.0f), 7.0f); a[4 * n + x] = (ul + 1.0f) * (gl * __builtin_amdgcn_rcpf(1.0f + __builtin_amdgcn_exp2f(-2.4554669595930156f * gl))); } }
#if MOE_FP8_DN
                if (pos < u.cnt && !(dry & 4)) { u32x2 w; w.x = pk4_fp8(a[0], a[1], a[2], a[3]); w.y = pk4_fp8(a[4], a[5], a[6], a[7]); *(u32x2*)((unsigned char*)ACT + (size_t)(u.rbase + pos) * DFF + f0) = w; } }
#else
                if (pos < u.cnt) { u32x4 w; w.x = pg8::cvt_pk_bf16(a[0], a[1]); w.y = pg8::cvt_pk_bf16(a[2], a[3]); w.z = pg8::cvt_pk_bf16(a[4], a[5]); w.w = pg8::cvt_pk_bf16(a[6], a[7]);
                    *(u32x4*)(ACT + (size_t)(u.rbase + pos) * DFF + f0) = w; } }
#endif
    }
};
struct EpiDown {
    static constexpr bool PERM = true; bf16_t* EO; const float* bdn; int dry;
    __device__ __forceinline__ void operator()(const f32x4 (&acc)[2][2][4][2], const pg8::Unit& u, int wr, int wc, int fr, int fq) const {
        if (dry & 1) return;
        const int col0 = u.pn * 256 + wc * 32 + 8 * fq; const float* bb = bdn + (size_t)u.e * DM;
        f32x4 bv[2][2];
#pragma unroll
        for (int bj = 0; bj < 2; ++bj)
#pragma unroll
            for (int n = 0; n < 2; ++n) bv[bj][n] = *(const f32x4*)(bb + col0 + bj * 128 + 4 * n);
#pragma unroll
        for (int ai = 0; ai < 2; ++ai)
#pragma unroll
            for (int m = 0; m < 4; ++m) { const int pos = u.pm * 256 + ai * 128 + wr * 64 + m * 16 + fr;
                if (pos < u.cnt) {
#pragma unroll
                    for (int bj = 0; bj < 2; ++bj) { const f32x4 v0 = acc[ai][bj][m][0] + bv[bj][0], v1 = acc[ai][bj][m][1] + bv[bj][1];
#if EOUT_FP8
                        u32x2 w; w.x = pk4_fp8(v0[0], v0[1], v0[2], v0[3]); w.y = pk4_fp8(v1[0], v1[1], v1[2], v1[3]);
                        *(u32x2*)((unsigned char*)EO + (size_t)(u.rbase + pos) * DM + col0 + bj * 128) = w; }
#else
                        u32x4 w; w.x = pg8::cvt_pk_bf16(v0[0], v0[1]); w.y = pg8::cvt_pk_bf16(v0[2], v0[3]); w.z = pg8::cvt_pk_bf16(v1[0], v1[1]); w.w = pg8::cvt_pk_bf16(v1[2], v1[3]);
                        *(u32x4*)(EO + (size_t)(u.rbase + pos) * DM + col0 + bj * 128) = w; }
#endif
                } }
    }
};

template <int MODE, bool OUT8 = false>
__device__ __forceinline__ void tr_item(const float* W, int K, int N, const float* ksc, bf16_t* WT, LAS float* scr, int item, int lane) {
    const int nblk = N / 32, kb = item / nblk, nb = item % nblk, k0 = 64 * kb, n0 = 32 * nb;
    { const int n4 = (lane & 7) * 4; f32x4 v[8];
#pragma unroll
      for (int i = 0; i < 8; ++i) v[i] = *(const f32x4*)(W + (size_t)(k0 + 8 * i + (lane >> 3)) * N + n0 + n4);
#pragma unroll
      for (int i = 0; i < 8; ++i) { const int kk = 8 * i + (lane >> 3); const float sc = ksc ? ksc[k0 + kk] : 1.0f; LAS float* d = scr + kk * 33 + n4; d[0] = v[i][0] * sc; d[1] = v[i][1] * sc; d[2] = v[i][2] * sc; d[3] = v[i][3] * sc; } }
    LDS_WAIT(); asm volatile("" ::: "memory");
    const int c = lane & 7;
#pragma unroll
    for (int j = 0; j < 4; ++j) { const int n = (lane >> 3) + 8 * j; const LAS float* s = scr + (8 * c) * 33 + n;
        u32x4 o; o.x = pk2(s[0 * 33], s[1 * 33]); o.y = pk2(s[2 * 33], s[3 * 33]); o.z = pk2(s[4 * 33], s[5 * 33]); o.w = pk2(s[6 * 33], s[7 * 33]);
        int row = n0 + n; if (MODE == 1) { const int isup = row >> 10, f = row & 1023; row = (f >> 7) * 256 + isup * 128 + (f & 127); }
        if constexpr (OUT8) { u32x2 o8; o8.x = pk4_fp8(32.f * s[0 * 33], 32.f * s[1 * 33], 32.f * s[2 * 33], 32.f * s[3 * 33]); o8.y = pk4_fp8(32.f * s[4 * 33], 32.f * s[5 * 33], 32.f * s[6 * 33], 32.f * s[7 * 33]);
            *(u32x2*)((unsigned char*)WT + (size_t)row * K + k0 + 8 * c) = o8; }
        else *(u32x4*)(WT + (size_t)row * K + k0 + 8 * c) = o; }
    LDS_WAIT(); asm volatile("" ::: "memory");
}
template <int MODE>
__device__ __forceinline__ void tr_item8(const float* W, int K, int N, const float* ksc, unsigned char* WT, LAS float* scr, int item, int lane) {
    const int nblk = N / 32, kb = item / nblk, nb = item % nblk, k0 = 128 * kb, n0 = 32 * nb;
    { const int n4 = (lane & 7) * 4; f32x4 v[16];
#pragma unroll
      for (int i = 0; i < 16; ++i) v[i] = *(const f32x4*)(W + (size_t)(k0 + 8 * i + (lane >> 3)) * N + n0 + n4);
#pragma unroll
      for (int i = 0; i < 16; ++i) { const int kk = 8 * i + (lane >> 3); const float sc = 32.f * (ksc ? ksc[k0 + kk] : 1.0f); LAS float* d = scr + kk * 33 + n4; d[0] = v[i][0] * sc; d[1] = v[i][1] * sc; d[2] = v[i][2] * sc; d[3] = v[i][3] * sc; } }
    LDS_WAIT(); asm volatile("" ::: "memory");
    const int c = lane & 7;
#pragma unroll
    for (int j = 0; j < 4; ++j) { const int n = (lane >> 3) + 8 * j; const LAS float* s = scr + (16 * c) * 33 + n;
        u32x4 o; o.x = pk4_fp8(s[0 * 33], s[1 * 33], s[2 * 33], s[3 * 33]); o.y = pk4_fp8(s[4 * 33], s[5 * 33], s[6 * 33], s[7 * 33]);
        o.z = pk4_fp8(s[8 * 33], s[9 * 33], s[10 * 33], s[11 * 33]); o.w = pk4_fp8(s[12 * 33], s[13 * 33], s[14 * 33], s[15 * 33]);
        int row = n0 + n; if (MODE == 1) { const int isup = row >> 10, f = row & 1023; row = (f >> 7) * 256 + isup * 128 + (f & 127); }
        *(u32x4*)(WT + (size_t)row * K + k0 + 16 * c) = o; }
    LDS_WAIT(); asm volatile("" ::: "memory");
}
__device__ __forceinline__ void rms_row_to_bf16(const float* xrow, bf16_t* orow, int lane) {
    const f32x4* xr = (const f32x4*)xrow + lane;
    f32x4 v[4]; float s = 0.f;
#pragma unroll
    for (int j = 0; j < 4; ++j) { v[j] = xr[64 * j]; s += (v[j].x * v[j].x + v[j].y * v[j].y) + (v[j].z * v[j].z + v[j].w * v[j].w); }
    const float rs = 1.f / sqrtf(wave_sum(s) * (1.f / DM) + 1e-5f);
    unsigned long long* o8 = (unsigned long long*)orow + lane;
#pragma unroll
    for (int j = 0; j < 4; ++j) o8[64 * j] = (unsigned long long)pk2(v[j].x * rs, v[j].y * rs) | ((unsigned long long)pk2(v[j].z * rs, v[j].w * rs) << 32);
}
__device__ __forceinline__ void phase_prologue(const Args& a, LAS unsigned char* lds, int wave, int lane) {
    LAS float* scr = (LAS float*)(lds + wave * 8704);
    const int gw = blockIdx.x * NWAVES + wave, NGW = gridDim.x * NWAVES;
    bf16_t* Wt_in = (bf16_t*)(a.ws + WS_WIN); bf16_t* Wt_out = (bf16_t*)(a.ws + WS_WOUT);
    constexpr int I_IN = (DM / 64) * (INW / 32), I_OUT = (DM / 64) * (DM / 32);
    for (int it = gw; it < I_IN + I_OUT; it += NGW) {
        if (it < I_IN) tr_item<0>(a.in[I_WIN], DM, INW, a.in[I_GMIX], Wt_in, scr, it, lane);
        else tr_item<0>(a.in[I_WOUT], DM, DM, nullptr, Wt_out, scr, it - I_IN, lane);
    }
    bf16_t* XN = (bf16_t*)(a.ws + WS_XN);
    for (int m = gw; m < MTOK; m += NGW) rms_row_to_bf16(a.in[I_X] + (size_t)m * DM, XN + (size_t)m * DM, lane);
}
__device__ __forceinline__ void expert_weight_items(const Args& a, LAS unsigned char* lds, int wave, int lane, int part, int nparts) {
    bf16_t* Wt_gu = (bf16_t*)(a.ws + WS_WGU); bf16_t* Wt_dn = (bf16_t*)(a.ws + WS_WDN);
#if MOE_FP8_GU && MOE_FP8_DN
    LAS float* scr = (LAS float*)(lds + wave * 16896);
    constexpr int I_GU = (DM / 128) * (2 * DFF / 32), I_DN = (DFF / 128) * (DM / 32);
    constexpr int NITEMS = NE * I_GU + NE * I_DN;
    for (int it = part * NWAVES + wave; it < NITEMS; it += nparts * NWAVES) {
        int r = it;
        if (r < NE * I_GU) { const int e = r / I_GU; tr_item8<1>(a.in[I_WGUP] + (size_t)e * DM * 2 * DFF, DM, 2 * DFF, a.in[I_GFFN], (unsigned char*)Wt_gu + (size_t)e * 2 * DFF * DM, scr, r % I_GU, lane); continue; } r -= NE * I_GU;
        { const int e = r / I_DN; tr_item8<0>(a.in[I_WDN] + (size_t)e * DFF * DM, DFF, DM, nullptr, (unsigned char*)Wt_dn + (size_t)e * DM * DFF, scr, r % I_DN, lane); }
    }
#else
    LAS float* scr = (LAS float*)(lds + wave * 8704);
    constexpr int I_GU = (DM / 64) * (2 * DFF / 32), I_DN = (DFF / 64) * (DM / 32);
    constexpr int NITEMS = NE * I_GU + NE * I_DN;
    for (int it = part * NWAVES + wave; it < NITEMS; it += nparts * NWAVES) {
        int r = it;
        if (r < NE * I_GU) { const int e = r / I_GU; tr_item<1, MOE_FP8_GU != 0>(a.in[I_WGUP] + (size_t)e * DM * 2 * DFF, DM, 2 * DFF, a.in[I_GFFN], (bf16_t*)((unsigned char*)Wt_gu + (size_t)e * 2 * DFF * DM * (MOE_FP8_GU ? 1 : 2)), scr, r % I_GU, lane); continue; } r -= NE * I_GU;
        { const int e = r / I_DN; tr_item<0, MOE_FP8_DN != 0>(a.in[I_WDN] + (size_t)e * DFF * DM, DFF, DM, nullptr, (bf16_t*)((unsigned char*)Wt_dn + (size_t)e * DM * DFF * (MOE_FP8_DN ? 1 : 2)), scr, r % I_DN, lane); }
    }
#endif
}

__device__ __forceinline__ int crow(int r, int hi) { return (r & 3) + 8 * (r >> 2) + 4 * hi; }
__device__ __forceinline__ s16x4 vtr(const LAS unsigned char* p) { typedef short v4i16_t __attribute__((ext_vector_type(4))); return __builtin_bit_cast(s16x4, __builtin_amdgcn_ds_read_tr16_b64_v4i16((LAS v4i16_t*)p)); }
constexpr int ATT_V_BYTES = 49152, ATT_WS_OFF = ATT_V_BYTES, ATT_OST_OFF = ATT_WS_OFF + NWAVES * 256;
__device__ __forceinline__ void attn_task(int T, const bf16_t* proj, bf16_t* opat, float* lse, LAS unsigned char* lds, int tid) {
    const int lane = tid & 63, wave = __builtin_amdgcn_readfirstlane(tid >> 6), r32 = lane & 31, hi = lane >> 5;
    const int b = T / 384, rem = T % 384, g = rem >> 7, h = (rem >> 4) & 7, sub = rem & 15;
    const int dl = (g == 0) ? 1 : (g == 1 ? 4 : 16);
    const int res = sub % dl, qb = sub / dl, u0 = qb * 256;
    const size_t rowb = (size_t)b * SEQ;
    { u32x4 vst[6];
#pragma unroll
      for (int i = 0; i < 6; ++i) { const int c = tid + i * NTHR, ku = c >> 3, ch = c & 7; int uk = u0 - 128 + ku; uk = uk < 0 ? 0 : uk;
          vst[i] = *(const u32x4*)(proj + (rowb + (size_t)uk * dl + res) * INW + 1024 + h * 64 + ch * 8); }
#pragma unroll
      for (int i = 0; i < 6; ++i) { const int c = tid + i * NTHR, ku = c >> 3, ch = c & 7;
          *(LAS u32x4*)(lds + (ch >> 2) * 24576 + (ku >> 4) * 1024 + (ku & 15) * 64 + (ch & 3) * 16) = vst[i]; } }
    int r32o = r32; asm volatile("" : "+v"(r32o));
    const int uq = u0 + 32 * wave + r32o; const size_t rowq = rowb + (size_t)uq * dl + res;
    bf16x8 qf[4];
#pragma unroll
    for (int ds = 0; ds < 4; ++ds) qf[ds] = *(const bf16x8*)(proj + rowq * INW + h * 64 + ds * 16 + hi * 8);
    f32x16 st[5];
#define ATT_KLOAD(dst, kt_) do { int rk = r32o; asm volatile("" : "+v"(rk)); int uk = u0 + 32 * wave - 128 + 32 * (kt_) + rk; if (uk < 0) uk = 0; \
        const bf16_t* kp = proj + (rowb + (size_t)uk * dl + res) * INW + 512 + h * 64 + hi * 8; \
        _Pragma("unroll") for (int ds = 0; ds < 4; ++ds) dst[ds] = *(const bf16x8*)(kp + ds * 16); } while (0)
    { bf16x8 kf[4], kn[4];
      ATT_KLOAD(kf, 0);
#pragma unroll
      for (int kt = 0; kt < 5; ++kt) {
          if (kt < 4) ATT_KLOAD(kn, kt + 1);
          f32x16 s = {};
#pragma unroll
          for (int ds = 0; ds < 4; ++ds) s = __builtin_amdgcn_mfma_f32_32x32x16_bf16(kf[ds], qf[ds], s, 0, 0, 0);
          st[kt] = s;
#pragma unroll
          for (int ds = 0; ds < 4; ++ds) kf[ds] = kn[ds]; } }
#undef ATT_KLOAD
    const float sl2 = exp2f(-(float)(h + 1)) * (float)dl * 1.4426950408889634f;
    const int dq = 128 + r32 - 4 * hi;
    int klo = 128 - u0 - 32 * wave - 4 * hi; if (dq - 128 > klo) klo = dq - 128;
    const float nb = -sl2 * (float)dq;
    float mx = -INFINITY;
#pragma unroll
    for (int kt = 0; kt < 5; ++kt)
#pragma unroll
        for (int r = 0; r < 16; ++r) { const int c = 32 * kt + (r & 3) + 8 * (r >> 2);
            float bias, sc; asm("v_fma_f32 %0, %1, %2, %3" : "=v"(bias) : "v"(sl2), "v"((float)c), "v"(nb));
            asm("v_fma_f32 %0, %1, %2, %3" : "=v"(sc) : "v"(st[kt][r]), "v"(0.18033688011112042f), "v"(bias));
            const bool ok = (c <= dq) && (c >= klo);
            sc = ok ? sc : -INFINITY; st[kt][r] = sc; mx = fmaxf(mx, sc); }
    mx = fmaxf(mx, __shfl_xor(mx, 32));
    float lsum = 0.f;
#pragma unroll
    for (int kt = 0; kt < 5; ++kt)
#pragma unroll
        for (int r = 0; r < 16; ++r) { float df; asm("v_sub_f32 %0, %1, %2" : "=v"(df) : "v"(st[kt][r]), "v"(mx)); const float p = __builtin_amdgcn_exp2f(df); st[kt][r] = p; lsum += p; }
    lsum += __shfl_xor(lsum, 32);
    __syncthreads();
    f32x16 o[2]; o[0] = f32x16{}; o[1] = f32x16{};
    const LAS unsigned char* vb = lds + ((lane >> 4) & 1) * 32 + (lane & 3) * 8 + (4 * hi + ((lane & 15) >> 2)) * 64;
#pragma unroll
    for (int kt = 0; kt < 5; ++kt)
#pragma unroll
        for (int s2 = 0; s2 < 2; ++s2) { const int kg = 2 * wave + 2 * kt + s2;
            u32x4 pw; pw.x = pk2(st[kt][8 * s2 + 0], st[kt][8 * s2 + 1]); pw.y = pk2(st[kt][8 * s2 + 2], st[kt][8 * s2 + 3]); pw.z = pk2(st[kt][8 * s2 + 4], st[kt][8 * s2 + 5]); pw.w = pk2(st[kt][8 * s2 + 6], st[kt][8 * s2 + 7]);
            const bf16x8 pa = __builtin_bit_cast(bf16x8, pw);
#pragma unroll
            for (int d0 = 0; d0 < 2; ++d0) { const LAS unsigned char* p = vb + d0 * 24576 + kg * 1024; const s16x4 lo = vtr(p), hh = vtr(p + 512);
                const bf16x8 vf = (bf16x8){lo[0], lo[1], lo[2], lo[3], hh[0], hh[1], hh[2], hh[3]};
                o[d0] = __builtin_amdgcn_mfma_f32_32x32x16_bf16(pa, vf, o[d0], 0, 0, 0); } asm volatile("" ::: "memory"); }
    LAS float* wsf = (LAS float*)(lds + ATT_WS_OFF) + wave * 64;
    if (hi == 0) wsf[r32] = __builtin_amdgcn_rcpf(lsum);
    LDS_WAIT();
    LAS bf16_t* stg = (LAS bf16_t*)(lds + ATT_OST_OFF) + wave * 2048;
#pragma unroll
    for (int r = 0; r < 16; ++r) { const int orow = crow(r, hi); const float li = wsf[orow];
#pragma unroll
        for (int d0 = 0; d0 < 2; ++d0) stg[orow * 64 + d0 * 32 + r32] = (bf16_t)f2bf(o[d0][r] * li); }
    LDS_WAIT();
    bf16_t* og = opat + (size_t)g * MTOK * 512;
#pragma unroll
    for (int i = 0; i < 4; ++i) { const int row = i * 8 + (lane >> 3), ch = lane & 7; const u32x4 v = *(const LAS u32x4*)(stg + row * 64 + ch * 8);
        const size_t tok = rowb + (size_t)(u0 + 32 * wave + row) * dl + res; *(u32x4*)(og + tok * 512 + h * 64 + ch * 8) = v; }
    if (hi == 0) lse[((size_t)g * MTOK + rowq) * NH + h] = (mx + __log2f(lsum)) * 0.6931471805599453f;
    __syncthreads();
}

constexpr int RT = 32;
__device__ __forceinline__ void rwkv_head(int b, int h, const Args& a, const bf16_t* proj, bf16_t* mix, LAS unsigned char* lds, int tid) {
    const int lane = tid & 63, wave = __builtin_amdgcn_readfirstlane(tid >> 6);
    LAS float* R_ = (LAS float*)lds;
    LAS float* KX = R_ + RT * 64; LAS float* V_ = KX + RT * 64; LAS float* WD = V_ + RT * 64; LAS float* AD = WD + RT * 64;
    LAS float* GD = AD + RT * 64;
    LAS float* DEC = GD + RT * 128; LAS float* KK = DEC + RT * 64; LAS float* BB = KK + RT * 64; LAS float* G_ = BB + RT * 64; LAS float* Y_ = G_ + RT * 64;
    const float* mu = a.in[I_MU];
    const int hc = h * 64 + lane;
    const float w0 = a.in[I_W0][hc], a0 = a.in[I_A0][hc], kkw = a.in[I_KK][hc], kaw = a.in[I_KA][hc], rkw = a.in[I_RK][hc], gnw = a.in[I_GNW][hc], gnb = a.in[I_GNB][hc];
    LAS bf16_t* WL = (LAS bf16_t*)(Y_ + RT * 64);
    __syncthreads();
    for (int i = tid; i < 256 * 64; i += NTHR) { const int l = i >> 6, c = i & 63; const float w = (l < 64) ? a.in[I_WDU][l * 512 + h * 64 + c] : (l < 128 ? a.in[I_WIU][(l - 64) * 512 + h * 64 + c] : a.in[I_WGU][(l - 128) * 512 + h * 64 + c]); WL[i] = (bf16_t)f2bf(w); }
    float Sx[8];
#pragma unroll
    for (int x = 0; x < 8; ++x) Sx[x] = 0.f;
    const int si = 8 * wave + (lane >> 3), jo = lane & 7;
    const size_t rowb = (size_t)b * SEQ;
    for (int blk = 0; blk < SEQ / RT; ++blk) {
        const int t0 = blk * RT;
        for (int it = tid; it < RT * 56; it += NTHR) { const int tt = it / 56, cc = it % 56;
            int col; LAS float* dst; int mode = 0;
            if (cc < 8) { col = 1536 + h * 64 + cc * 8; dst = R_ + tt * 64 + cc * 8; }
            else if (cc < 16) { col = 2048 + h * 64 + (cc - 8) * 8; dst = KX + tt * 64 + (cc - 8) * 8; }
            else if (cc < 24) { col = 2560 + h * 64 + (cc - 16) * 8; dst = V_ + tt * 64 + (cc - 16) * 8; }
            else if (cc < 32) { col = 3072 + (cc - 24) * 8; dst = WD + tt * 64 + (cc - 24) * 8; mode = 1; }
            else if (cc < 40) { col = 3136 + (cc - 32) * 8; dst = AD + tt * 64 + (cc - 32) * 8; }
            else { col = 3200 + (cc - 40) * 8; dst = GD + tt * 128 + (cc - 40) * 8; mode = 2; }
            const bf16_t* p = proj + (rowb + t0 + tt) * INW + col;
            const u32x4 cu = *(const u32x4*)p; u32x4 pv = (u32x4){0u, 0u, 0u, 0u}; if (t0 + tt > 0) pv = *(const u32x4*)(p - INW);
            const f32x4 m0 = *(const f32x4*)(mu + col - 1536), m1 = *(const f32x4*)(mu + col - 1536 + 4);
            float o[8];
#pragma unroll
            for (int q = 0; q < 4; ++q) { const float c0 = bflo(cu[q]), c1 = bfhi(cu[q]), p0 = bflo(pv[q]), p1 = bfhi(pv[q]); const float ma = (q < 2) ? m0[2 * q] : m1[2 * q - 4], mb = (q < 2) ? m0[2 * q + 1] : m1[2 * q - 3];
                o[2 * q] = c0 + (p0 - c0) * ma; o[2 * q + 1] = c1 + (p1 - c1) * mb; }
#pragma unroll
            for (int q = 0; q < 8; ++q) { float v = o[q]; if (mode == 1) v = tanhf(v); else if (mode == 2) v = sigmoidf_(v); dst[q] = v; }
        }
        __syncthreads();
        {
            float wp[4], ap[4], gp[4];
#pragma unroll
            for (int i = 0; i < 4; ++i) { wp[i] = w0; ap[i] = a0; gp[i] = 0.f; }
#pragma unroll 2
            for (int l = 0; l < 64; l += 4) {
                float wd[4], wi[4];
#pragma unroll
                for (int q = 0; q < 4; ++q) { wd[q] = bf2f(WL[(l + q) * 64 + lane]); wi[q] = bf2f(WL[(64 + l + q) * 64 + lane]); }
#pragma unroll
                for (int i = 0; i < 4; ++i) { const f32x4 xw = *(const LAS f32x4*)(WD + (4 * wave + i) * 64 + l), xa = *(const LAS f32x4*)(AD + (4 * wave + i) * 64 + l);
                    wp[i] += xw[0] * wd[0] + xw[1] * wd[1] + xw[2] * wd[2] + xw[3] * wd[3]; ap[i] += xa[0] * wi[0] + xa[1] * wi[1] + xa[2] * wi[2] + xa[3] * wi[3]; } }
#pragma unroll 2
            for (int l = 0; l < 128; l += 4) {
                float wg[4];
#pragma unroll
                for (int q = 0; q < 4; ++q) wg[q] = bf2f(WL[(128 + l + q) * 64 + lane]);
#pragma unroll
                for (int i = 0; i < 4; ++i) { const f32x4 xg = *(const LAS f32x4*)(GD + (4 * wave + i) * 128 + l); gp[i] += xg[0] * wg[0] + xg[1] * wg[1] + xg[2] * wg[2] + xg[3] * wg[3]; } }
#pragma unroll
            for (int i = 0; i < 4; ++i) { const int tt = 4 * wave + i;
                const float z = -wp[i]; const float sp = fmaxf(z, 0.f) + log1pf(__expf(-fabsf(z)));
                const float w = -sp - 0.5f; const float dec = __expf(-__expf(w));
                const float av = sigmoidf_(ap[i]);
                const float kx = KX[tt * 64 + lane]; const float kr = kx * kkw; const float n2 = wave_sum(kr * kr);
                const float kk = kr / fmaxf(sqrtf(n2), 1e-12f);
                DEC[tt * 64 + lane] = dec; KK[tt * 64 + lane] = kk; BB[tt * 64 + lane] = kk * av; KX[tt * 64 + lane] = kx * (1.0f + (av - 1.0f) * kaw); G_[tt * 64 + lane] = gp[i]; }
        }
        __syncthreads();
#pragma unroll 2
        for (int s = 0; s < RT; ++s) {
            const f32x4 k0 = *(const LAS f32x4*)(KK + s * 64 + 8 * jo), k1 = *(const LAS f32x4*)(KK + s * 64 + 8 * jo + 4);
            float sa = Sx[0] * k0[0] + Sx[1] * k0[1] + Sx[2] * k0[2] + Sx[3] * k0[3] + Sx[4] * k1[0] + Sx[5] * k1[1] + Sx[6] * k1[2] + Sx[7] * k1[3];
            sa = sum8(sa);
            const f32x4 d0 = *(const LAS f32x4*)(DEC + s * 64 + 8 * jo), d1 = *(const LAS f32x4*)(DEC + s * 64 + 8 * jo + 4);
            const f32x4 b0 = *(const LAS f32x4*)(BB + s * 64 + 8 * jo), b1 = *(const LAS f32x4*)(BB + s * 64 + 8 * jo + 4);
            const f32x4 x0 = *(const LAS f32x4*)(KX + s * 64 + 8 * jo), x1 = *(const LAS f32x4*)(KX + s * 64 + 8 * jo + 4);
            const f32x4 r0 = *(const LAS f32x4*)(R_ + s * 64 + 8 * jo), r1 = *(const LAS f32x4*)(R_ + s * 64 + 8 * jo + 4);
            const float vi = V_[s * 64 + si];
            float y = 0.f;
#pragma unroll
            for (int x = 0; x < 4; ++x) { Sx[x] = Sx[x] * d0[x] - sa * b0[x] + vi * x0[x]; y += Sx[x] * r0[x]; Sx[4 + x] = Sx[4 + x] * d1[x] - sa * b1[x] + vi * x1[x]; y += Sx[4 + x] * r1[x]; }
            y = sum8(y);
            if (jo == 0) Y_[s * 64 + si] = y;
        }
        __syncthreads();
#pragma unroll
        for (int i = 0; i < 4; ++i) { const int tt = 4 * wave + i;
            const float y = Y_[tt * 64 + lane]; const float mean = wave_sum(y) * (1.f / 64.f); const float dv = y - mean; const float var = wave_sum(dv * dv) * (1.f / 64.f);
            const float yn = dv * (1.0f / sqrtf(var + 64e-5f)) * gnw + gnb;
            const float bs = wave_sum(R_[tt * 64 + lane] * KX[tt * 64 + lane] * rkw);
            const float ov = (yn + bs * V_[tt * 64 + lane]) * G_[tt * 64 + lane];
            mix[(rowb + t0 + tt) * DM + 512 + hc] = (bf16_t)f2bf(ov); }
        __syncthreads();
    }
}

namespace rk {
constexpr int SLOT = 8192, LDF = 68;
constexpr int O_F0 = 16 * SLOT, O_NP = O_F0 + 64 * LDF * 4, O_BP = O_NP + 2048, O_GAM = O_BP + 2048, O_CST = O_GAM + 256, O_END = O_CST + 5 * 64 * 4;
__device__ __forceinline__ int AD(int r, int c) { return (r << 6) + ((((c >> 3) ^ r) & 7) << 3) + (c & 7); }
__device__ __forceinline__ int AD2(int r, int c) { return (r << 7) + ((((c >> 3) ^ r) & 15) << 3) + (c & 7); }
__device__ __forceinline__ void mm(const LAS bf16_t* Bs, const LAS bf16_t* As, int qb, int pb0, int fr, int kq, f32x4 (&acc)[2]) {
#pragma unroll
    for (int ks = 0; ks < 2; ++ks) { const bf16x8 a = *(const LAS bf16x8*)(As + AD(16 * qb + fr, 32 * ks + 8 * kq));
#pragma unroll
        for (int c = 0; c < 2; ++c) { const bf16x8 b = *(const LAS bf16x8*)(Bs + AD(16 * (pb0 + c) + fr, 32 * ks + 8 * kq)); acc[c] = __builtin_amdgcn_mfma_f32_16x16x32_bf16(a, b, acc[c], 0, 0, 0); } }
}
struct Frag { bf16x8 a[2]; bf16x8 b[2][2]; };
__device__ __forceinline__ void ldf(Frag& f, const LAS bf16_t* Bs, const LAS bf16_t* As, int qb, int pb0, int fr, int kq) {
#pragma unroll
    for (int ks = 0; ks < 2; ++ks) { f.a[ks] = *(const LAS bf16x8*)(As + AD(16 * qb + fr, 32 * ks + 8 * kq));
#pragma unroll
        for (int c = 0; c < 2; ++c) f.b[c][ks] = *(const LAS bf16x8*)(Bs + AD(16 * (pb0 + c) + fr, 32 * ks + 8 * kq)); }
}
__device__ __forceinline__ void mmf(const Frag& f, f32x4 (&acc)[2]) {
#pragma unroll
    for (int ks = 0; ks < 2; ++ks)
#pragma unroll
        for (int c = 0; c < 2; ++c) acc[c] = __builtin_amdgcn_mfma_f32_16x16x32_bf16(f.a[ks], f.b[c][ks], acc[c], 0, 0, 0);
}
__device__ __forceinline__ void mmt(const Frag& f, f32x4 (&acc)[2]) {
#pragma unroll
    for (int ks = 0; ks < 2; ++ks)
#pragma unroll
        for (int c = 0; c < 2; ++c) acc[c] = __builtin_amdgcn_mfma_f32_16x16x32_bf16(f.b[c][ks], f.a[ks], acc[c], 0, 0, 0);
}
#define RK_LOADED() do { __builtin_amdgcn_sched_barrier(0); } while (0)
__device__ __forceinline__ void st4(LAS bf16_t* O, int p, int q0, const f32x4 v) { u32x2 w; w.x = pk2(v[0], v[1]); w.y = pk2(v[2], v[3]); *(LAS u32x2*)(O + AD(p, q0)) = w; }
__device__ __forceinline__ f32x4 ld4(const LAS bf16_t* O, int p, int q0) { const u32x2 w = *(const LAS u32x2*)(O + AD(p, q0)); return (f32x4){bflo(w.x), bfhi(w.x), bflo(w.y), bfhi(w.y)}; }
__device__ __forceinline__ float ex2(float x) { return __builtin_amdgcn_exp2f(x); }
#define RK_ZERO(a) do { a[0] = (f32x4){0.f, 0.f, 0.f, 0.f}; a[1] = (f32x4){0.f, 0.f, 0.f, 0.f}; } while (0)
#define RK_BAR() do { asm volatile("s_waitcnt lgkmcnt(0)" ::: "memory"); __builtin_amdgcn_s_barrier(); asm volatile("" ::: "memory"); } while (0)
}
__device__ __forceinline__ void rwkv_head_chunked(int b, int h, const Args& a, const bf16_t* proj, bf16_t* mix, LAS unsigned char* lds, int tid, const unsigned skip = 0u) {
    using namespace rk;
    const int lane0 = tid & 63, wave = __builtin_amdgcn_readfirstlane(tid >> 6), fr0 = lane0 & 15, kq0 = lane0 >> 4;
    const int qb = wave >> 1, pb0 = 2 * (wave & 1);
    const float L2E = 1.4426950408889634f;
#define SL(i) ((LAS bf16_t*)(lds + (i) * SLOT))
#define SLF(i) ((LAS float*)(lds + (i) * SLOT))
    LAS bf16_t* const SG = SL(0); LAS bf16_t* const SS = SL(1);
    LAS float* const F0 = (LAS float*)(lds + O_F0);
    LAS float* const NP = (LAS float*)(lds + O_NP); LAS float* const BP = (LAS float*)(lds + O_BP); LAS float* const GAM = (LAS float*)(lds + O_GAM);
    const size_t rowb = (size_t)b * SEQ;
    __syncthreads();
    for (int i = tid; i < 64 * 64 / 2; i += NTHR) ((LAS unsigned*)SS)[i] = 0u;
    bf16x8 wfd[2], wfa[2], wfg[4];
    if (skip & 4096u) { wfd[0] = wfd[1] = wfa[0] = wfa[1] = wfg[0] = wfg[1] = wfg[2] = wfg[3] = (bf16x8){0, 0, 0, 0, 0, 0, 0, 0}; } else
    { const int c = h * 64 + 16 * qb + fr0;
#pragma unroll
      for (int ks = 0; ks < 2; ++ks) { u32x4 d, e;
#pragma unroll
          for (int j = 0; j < 4; ++j) { const int l = 32 * ks + 8 * kq0 + 2 * j; d[j] = pk2(a.in[I_WDU][l * 512 + c], a.in[I_WDU][(l + 1) * 512 + c]); e[j] = pk2(a.in[I_WIU][l * 512 + c], a.in[I_WIU][(l + 1) * 512 + c]); }
          wfd[ks] = __builtin_bit_cast(bf16x8, d); wfa[ks] = __builtin_bit_cast(bf16x8, e); }
#pragma unroll
      for (int ks = 0; ks < 4; ++ks) { u32x4 d;
#pragma unroll
          for (int j = 0; j < 4; ++j) { const int l = 32 * ks + 8 * kq0 + 2 * j; d[j] = pk2(a.in[I_WGU][l * 512 + c], a.in[I_WGU][(l + 1) * 512 + c]); }
          wfg[ks] = __builtin_bit_cast(bf16x8, d); } }
    const int j0 = 8 * wave;
    LAS float* const CST = (LAS float*)(lds + O_CST);
    if (tid < 320) { const int which = tid >> 6, c = tid & 63; const float* src = (which == 0) ? a.in[I_W0] : (which == 1) ? a.in[I_A0] : (which == 2) ? a.in[I_KK] : (which == 3) ? a.in[I_KA] : a.in[I_RK]; CST[tid] = src[h * 64 + c]; }
#define c_w0 (CST + 0 + j0)
#define c_a0 (CST + 64 + j0)
#define c_kk (CST + 128 + j0)
#define c_ka (CST + 192 + j0)
#define c_rk (CST + 256 + j0)
    const float gnw = a.in[I_GNW][h * 64 + lane0], gnb = a.in[I_GNB][h * 64 + lane0];
    const int gA = (int)((0x53012764u >> (4 * wave)) & 15u) - 1, gB = (int)((0x25107364u >> (4 * wave)) & 15u) - 1;
    const int tr = lane0 >> 3, c8 = lane0 & 7;
    auto gcol = [&](int g) { return (g < 3 ? 1536 + 512 * g + h * 64 : 3072 + 64 * (g - 3)) + 8 * c8; };
    const int colA = gcol(gA < 0 ? 0 : gA), colB = gcol(gB < 0 ? 0 : gB);
    float muA[8], muB[8];
    { const f32x4 m0 = *(const f32x4*)(a.in[I_MU] + colA - 1536), m1 = *(const f32x4*)(a.in[I_MU] + colA - 1536 + 4), m2 = *(const f32x4*)(a.in[I_MU] + colB - 1536), m3 = *(const f32x4*)(a.in[I_MU] + colB - 1536 + 4);
#pragma unroll
      for (int x = 0; x < 4; ++x) { muA[x] = m0[x]; muA[4 + x] = m1[x]; muB[x] = m2[x]; muB[4 + x] = m3[x]; } }
    u32x4 rawA[5], rawB[5];
    const bf16_t* gsrc = proj + (rowb + 8 * tr) * INW;
#define RK_PREFETCH(t0_) do { \
        if (gA >= 0) { const int tf_ = (t0_) + 8 * tr - 1; rawA[0] = *(const u32x4*)(gsrc + colA + ((long)(tf_ < 0 ? 0 : tf_) - 8 * tr) * INW); \
            _Pragma("unroll") for (int q = 1; q < 5; ++q) rawA[q] = *(const u32x4*)(gsrc + colA + ((long)(t0_) + q - 1) * INW); } \
        if (gB >= 0) { _Pragma("unroll") for (int q = 0; q < 5; ++q) rawB[q] = *(const u32x4*)(gsrc + colB + ((long)(t0_) + q + 3) * INW); } } while (0)
    RK_PREFETCH(0);
    RK_BAR();
#pragma unroll 1
    for (int ch = 0; ch < SEQ / 64; ++ch) {
        const int t0 = ch * 64;
        int tl_ = tid; asm volatile("" : "+v"(tl_));
        const int lane = tl_ & 63, fr = lane & 15, kq = lane >> 4;
        if (!(skip & 1u)) {
            int tro_ = tr; asm volatile("" : "+v"(tro_));
#define RK_PA_HALF(RAW, MU, G, QB) do { const int g_ = (G); const int mode = (g_ == 3) ? 1 : (g_ >= 5 ? 2 : (g_ == 1 ? 3 : 0)); \
            const int dslot = (g_ == 0) ? 2 : (g_ == 1) ? 7 : (g_ == 2) ? 4 : (g_ == 3) ? 3 : (g_ == 4) ? 9 : 5; \
            _Pragma("unroll") for (int q = 0; q < 4; ++q) { const u32x4 cu = RAW[q + 1]; u32x4 pv = RAW[q]; if ((QB) == 0 && q == 0 && t0 + tr == 0) pv = (u32x4){0u, 0u, 0u, 0u}; float o[8]; \
                _Pragma("unroll") for (int x = 0; x < 4; ++x) { const float c0 = bflo(cu[x]), c1 = bfhi(cu[x]), p0 = bflo(pv[x]), p1 = bfhi(pv[x]); o[2 * x] = c0 + (p0 - c0) * MU[2 * x]; o[2 * x + 1] = c1 + (p1 - c1) * MU[2 * x + 1]; } \
                if (mode == 1) { _Pragma("unroll") for (int x = 0; x < 8; ++x) o[x] = 1.0f - 2.0f * __builtin_amdgcn_rcpf(1.0f + ex2(o[x] * (2.0f * L2E))); } \
                else if (mode == 2) { _Pragma("unroll") for (int x = 0; x < 8; ++x) o[x] = __builtin_amdgcn_rcpf(1.0f + ex2(-o[x] * L2E)); } \
                u32x4 w; w.x = pk2(o[0], o[1]); w.y = pk2(o[2], o[3]); w.z = pk2(o[4], o[5]); w.w = pk2(o[6], o[7]); \
                { const int row = 8 * tro_ + (QB) + q; LAS bf16_t* dimg = (LAS bf16_t*)(lds + dslot * SLOT); *(LAS u32x4*)(dimg + ((g_ < 5) ? AD(row, 8 * c8_) : AD2(row, 8 * c8_ + 64 * (g_ - 5)))) = w; } \
                if (mode == 3) { float n2 = 0.f; \
                    _Pragma("unroll") for (int x = 0; x < 8; ++x) { const float kr_ = o[x] * CST[128 + 8 * c8_ + x]; n2 += kr_ * kr_; } \
                    n2 = sum8(n2); if (c8_ == 0) NP[8 * tr + (QB) + q] = n2; } } } while (0)
            const int c8_ = lane & 7;
            if (gA >= 0) RK_PA_HALF(rawA, muA, gA, 0);
            if (gB >= 0) RK_PA_HALF(rawB, muB, gB, 4);
#undef RK_PA_HALF
        }
        if (!(skip & 2048u)) RK_BAR();
        if (!(skip & 2u)) { f32x4 aw[2], aa[2], ag[2]; RK_ZERO(aw); RK_ZERO(aa); RK_ZERO(ag);
          bf16x8 bw[2][2], ba[2][2], bg[4][2];
#pragma unroll
          for (int c = 0; c < 2; ++c) { const int t = 16 * (pb0 + c) + fr;
#pragma unroll
              for (int ks = 0; ks < 2; ++ks) { bw[ks][c] = *(const LAS bf16x8*)(SL(3) + AD(t, 32 * ks + 8 * kq)); ba[ks][c] = *(const LAS bf16x8*)(SL(9) + AD(t, 32 * ks + 8 * kq)); }
#pragma unroll
              for (int ks = 0; ks < 4; ++ks) bg[ks][c] = *(const LAS bf16x8*)(SL(5) + AD2(t, 32 * ks + 8 * kq)); }
          RK_LOADED();
#pragma unroll
          for (int c = 0; c < 2; ++c) {
#pragma unroll
              for (int ks = 0; ks < 2; ++ks) { aw[c] = __builtin_amdgcn_mfma_f32_16x16x32_bf16(wfd[ks], bw[ks][c], aw[c], 0, 0, 0); aa[c] = __builtin_amdgcn_mfma_f32_16x16x32_bf16(wfa[ks], ba[ks][c], aa[c], 0, 0, 0); }
#pragma unroll
              for (int ks = 0; ks < 4; ++ks) ag[c] = __builtin_amdgcn_mfma_f32_16x16x32_bf16(wfg[ks], bg[ks][c], ag[c], 0, 0, 0); }
#pragma unroll
          for (int c = 0; c < 2; ++c) { const int t = 16 * (pb0 + c) + fr, q0 = 16 * qb + 4 * kq;
              *(LAS f32x4*)(F0 + t * LDF + q0) = aw[c]; st4(SL(8), t, q0, aa[c]); st4(SG, t, q0, ag[c]); } }
        if (!(skip & 2048u)) RK_BAR();
        if (!(skip & 4u)) {
          const int rj = AD(lane, j0);
          const u32x4 xk = *(const LAS u32x4*)(SL(7) + rj), xr = *(const LAS u32x4*)(SL(2) + rj), xv = *(const LAS u32x4*)(SL(4) + rj), xa = *(const LAS u32x4*)(SL(8) + rj);
          const f32x4 w0v = *(const LAS f32x4*)(F0 + lane * LDF + j0), w1v = *(const LAS f32x4*)(F0 + lane * LDF + j0 + 4);
          const float rn = __builtin_amdgcn_rsqf(fmaxf(NP[lane], 1e-24f));
          float cw0[8], ca0[8], ckk[8], cka[8], crk[8];
          { const f32x4 t0_ = *(const LAS f32x4*)(CST + j0), t1_ = *(const LAS f32x4*)(CST + j0 + 4), t2_ = *(const LAS f32x4*)(CST + 64 + j0), t3_ = *(const LAS f32x4*)(CST + 64 + j0 + 4);
            const f32x4 t4_ = *(const LAS f32x4*)(CST + 128 + j0), t5_ = *(const LAS f32x4*)(CST + 128 + j0 + 4), t6_ = *(const LAS f32x4*)(CST + 192 + j0), t7_ = *(const LAS f32x4*)(CST + 192 + j0 + 4);
            const f32x4 t8_ = *(const LAS f32x4*)(CST + 256 + j0), t9_ = *(const LAS f32x4*)(CST + 256 + j0 + 4);
#pragma unroll
            for (int x = 0; x < 4; ++x) { cw0[x] = t0_[x]; cw0[4 + x] = t1_[x]; ca0[x] = t2_[x]; ca0[4 + x] = t3_[x]; ckk[x] = t4_[x]; ckk[4 + x] = t5_[x]; cka[x] = t6_[x]; cka[4 + x] = t7_[x]; crk[x] = t8_[x]; crk[4 + x] = t9_[x]; } }
          float kap[8], bet[8], kt[8], rt[8], bg[8], kg[8], bpart = 0.f, lwv[8], cl[8], glv[8];
#pragma unroll
          for (int x = 0; x < 8; ++x) { const float wp = ((x < 4) ? w0v[x] : w1v[x - 4]) + cw0[x]; lwv[x] = (-L2E * 0.6065306597126334f) * __builtin_amdgcn_rcpf(1.0f + ex2(-wp * L2E)); }
#pragma unroll
          for (int x = 0; x < 8; ++x) cl[x] = scan64(lwv[x]);
#pragma unroll
          for (int x = 0; x < 8; ++x) {
              const float kxv = (x & 1) ? bfhi(xk[x >> 1]) : bflo(xk[x >> 1]), r = (x & 1) ? bfhi(xr[x >> 1]) : bflo(xr[x >> 1]);
              const float ap = ((x & 1) ? bfhi(xa[x >> 1]) : bflo(xa[x >> 1])) + ca0[x];
              const float avv = __builtin_amdgcn_rcpf(1.0f + ex2(-ap * L2E));
              const float clL = __builtin_bit_cast(float, __builtin_amdgcn_readlane(__builtin_bit_cast(int, cl[x]), 63));
              const float emc = ex2(-cl[x]), epc = __builtin_amdgcn_rcpf(emc), epx = ex2(lwv[x] * -1.0f + cl[x]), egl = ex2(clL - cl[x]);
              const float kk = kxv * ckk[x] * rn, bq = kk * avv, km = kxv * (1.0f + (avv - 1.0f) * cka[x]);
              kap[x] = epx * kk; bet[x] = bq * emc; kt[x] = km * emc; rt[x] = r * epc; bg[x] = bq * egl; kg[x] = km * egl;
              bpart += r * km * crk[x];
              glv[x] = epc; }
          if (lane == 63) { *(LAS f32x4*)(GAM + j0) = (f32x4){glv[0], glv[1], glv[2], glv[3]}; *(LAS f32x4*)(GAM + j0 + 4) = (f32x4){glv[4], glv[5], glv[6], glv[7]}; }
          BP[wave * 64 + lane] = bpart;
          u32x4 w;
          w.x = pk2(kap[0], kap[1]); w.y = pk2(kap[2], kap[3]); w.z = pk2(kap[4], kap[5]); w.w = pk2(kap[6], kap[7]); *(LAS u32x4*)(SL(9) + rj) = w;
          w.x = pk2(bet[0], bet[1]); w.y = pk2(bet[2], bet[3]); w.z = pk2(bet[4], bet[5]); w.w = pk2(bet[6], bet[7]); *(LAS u32x4*)(SL(10) + rj) = w;
          w.x = pk2(kt[0], kt[1]); w.y = pk2(kt[2], kt[3]); w.z = pk2(kt[4], kt[5]); w.w = pk2(kt[6], kt[7]); *(LAS u32x4*)(SL(11) + rj) = w;
          w.x = pk2(rt[0], rt[1]); w.y = pk2(rt[2], rt[3]); w.z = pk2(rt[4], rt[5]); w.w = pk2(rt[6], rt[7]); *(LAS u32x4*)(SL(12) + rj) = w;
#pragma unroll
          for (int x = 0; x < 8; ++x) { const int tj = AD(j0 + x, lane); SL(5)[tj] = (bf16_t)f2bf(kap[x]); SL(6)[tj] = (bf16_t)f2bf(bg[x]); SL(3)[tj] = (bf16_t)f2bf(kg[x]);
              SL(13)[tj] = (bf16_t)((x & 1) ? (xv[x >> 1] >> 16) : (xv[x >> 1] & 0xffffu)); } }
        if (!(skip & 2048u)) RK_BAR();
        if (ch + 1 < SEQ / 64 && !(skip & 1024u)) RK_PREFETCH(t0 + 64);
        const int q0 = 16 * qb + 4 * kq;
        if (!(skip & 32u)) { f32x4 a1[2], a2[2], a3[2], a4[2], a5[2]; RK_ZERO(a1); RK_ZERO(a2); RK_ZERO(a3); RK_ZERO(a4); RK_ZERO(a5);
          { Frag f1, f3; ldf(f1, SL(9), SL(10), qb, pb0, fr, kq); ldf(f3, SL(11), SL(9), qb, pb0, fr, kq); RK_LOADED();
            mmf(f1, a1);
            mmt(f1, a2);
            mmf(f3, a3); }
          { Frag f4, f5; ldf(f4, SL(12), SL(10), qb, pb0, fr, kq); ldf(f5, SL(12), SL(11), qb, pb0, fr, kq); RK_LOADED();
            mmf(f4, a4);
            mmf(f5, a5); }
#pragma unroll
          for (int c = 0; c < 2; ++c) { const int p = 16 * (pb0 + c) + fr;
#pragma unroll
              for (int x = 0; x < 4; ++x) { const int q = q0 + x; a1[c][x] = (q < p) ? a1[c][x] : 0.f; a2[c][x] = (16 * qb + fr < 16 * (pb0 + c) + 4 * kq + x) ? a2[c][x] : 0.f; a3[c][x] = (p < q) ? a3[c][x] : 0.f; a4[c][x] = (q <= p) ? a4[c][x] : 0.f; a5[c][x] = (q <= p) ? a5[c][x] : 0.f; }
              st4(SL(2), p, q0, a1[c]); st4(SL(4), 16 * qb + fr, 16 * (pb0 + c) + 4 * kq, a2[c]); st4(SL(7), p, q0, a3[c]); st4(SL(8), p, q0, a4[c]); st4(SL(14), p, q0, a5[c]); } }
        if (!(skip & 2048u)) RK_BAR();
        if (!(skip & 64u)) { f32x4 a1[2], a2[2]; RK_ZERO(a1); RK_ZERO(a2);
          { Frag f1; ldf(f1, SL(2), SL(4), qb, pb0, fr, kq); RK_LOADED();
            mmf(f1, a1);
            mmt(f1, a2); }
#pragma unroll
          for (int c = 0; c < 2; ++c) { const int p = 16 * (pb0 + c) + fr; st4(SL(9), p, q0, a1[c]); st4(SL(10), 16 * qb + fr, 16 * (pb0 + c) + 4 * kq, a2[c]); } }
        if (!(skip & 2048u)) RK_BAR();
        if (!(skip & 64u)) { f32x4 a1[2], a2[2], a3[2]; RK_ZERO(a1); RK_ZERO(a2); RK_ZERO(a3);
          f32x4 x1[2];
          { Frag f1, f3; ldf(f1, SL(9), SL(10), qb, pb0, fr, kq); ldf(f3, SL(2), SL(10), qb, pb0, fr, kq);
            f32x4 pv[2], qv[2];
#pragma unroll
            for (int c = 0; c < 2; ++c) { const int p = 16 * (pb0 + c) + fr; pv[c] = ld4(SL(2), p, q0); qv[c] = ld4(SL(9), p, q0); }
            RK_LOADED();
            mmf(f1, a1); mmt(f1, a2); mmf(f3, a3);
#pragma unroll
            for (int c = 0; c < 2; ++c) { const int p = 16 * (pb0 + c) + fr;
#pragma unroll
                for (int x = 0; x < 4; ++x) x1[c][x] = ((q0 + x == p) ? 1.0f : 0.0f) - pv[c][x] + qv[c][x] - a3[c][x]; } }
#pragma unroll
          for (int c = 0; c < 2; ++c) { const int p = 16 * (pb0 + c) + fr; st4(SL(11), p, q0, a1[c]); st4(SL(4), 16 * qb + fr, 16 * (pb0 + c) + 4 * kq, a2[c]); st4(SL(15), p, q0, x1[c]); } }
        if (!(skip & 2048u)) RK_BAR();
        if (!(skip & 64u)) { f32x4 a1[2], a2[2], a3[2]; RK_ZERO(a1); RK_ZERO(a2); RK_ZERO(a3);
          { Frag f1, f3; ldf(f1, SL(11), SL(4), qb, pb0, fr, kq); ldf(f3, SL(15), SL(4), qb, pb0, fr, kq);
#pragma unroll
            for (int c = 0; c < 2; ++c) a3[c] = ld4(SL(15), 16 * (pb0 + c) + fr, q0);
            RK_LOADED(); mmf(f1, a1); mmt(f1, a2); mmf(f3, a3); }
#pragma unroll
          for (int c = 0; c < 2; ++c) { const int p = 16 * (pb0 + c) + fr; st4(SL(2), p, q0, a1[c]); st4(SL(9), 16 * qb + fr, 16 * (pb0 + c) + 4 * kq, a2[c]); st4(SL(10), p, q0, a3[c]); } }
        if (!(skip & 2048u)) RK_BAR();
        if (!(skip & 64u)) { f32x4 a1[2], a2[2], a3[2]; RK_ZERO(a1); RK_ZERO(a2); RK_ZERO(a3);
          { Frag f1, f3; ldf(f1, SL(2), SL(9), qb, pb0, fr, kq); ldf(f3, SL(10), SL(9), qb, pb0, fr, kq);
#pragma unroll
            for (int c = 0; c < 2; ++c) a3[c] = ld4(SL(10), 16 * (pb0 + c) + fr, q0);
            RK_LOADED(); mmf(f1, a1); mmt(f1, a2); mmf(f3, a3); }
#pragma unroll
          for (int c = 0; c < 2; ++c) { const int p = 16 * (pb0 + c) + fr; st4(SL(11), p, q0, a1[c]); st4(SL(4), 16 * qb + fr, 16 * (pb0 + c) + 4 * kq, a2[c]); st4(SL(15), p, q0, a3[c]); } }
        if (!(skip & 2048u)) RK_BAR();
        if (!(skip & 64u)) { f32x4 a2[2], a3[2]; RK_ZERO(a2); RK_ZERO(a3);
          { Frag f1, f3; ldf(f1, SL(11), SL(4), qb, pb0, fr, kq); ldf(f3, SL(15), SL(4), qb, pb0, fr, kq);
#pragma unroll
            for (int c = 0; c < 2; ++c) a3[c] = ld4(SL(15), 16 * (pb0 + c) + fr, q0);
            RK_LOADED(); mmt(f1, a2); mmf(f3, a3); }
#pragma unroll
          for (int c = 0; c < 2; ++c) { const int p = 16 * (pb0 + c) + fr; st4(SL(9), 16 * qb + fr, 16 * (pb0 + c) + 4 * kq, a2[c]); st4(SL(10), p, q0, a3[c]); } }
        if (!(skip & 2048u)) RK_BAR();
        if (!(skip & 64u)) { f32x4 a3[2]; RK_ZERO(a3);
          { Frag f3; ldf(f3, SL(10), SL(9), qb, pb0, fr, kq);
#pragma unroll
            for (int c = 0; c < 2; ++c) a3[c] = ld4(SL(10), 16 * (pb0 + c) + fr, q0);
            RK_LOADED(); mmf(f3, a3); }
#pragma unroll
          for (int c = 0; c < 2; ++c) st4(SL(15), 16 * (pb0 + c) + fr, q0, a3[c]); }
        if (!(skip & 2048u)) RK_BAR();
        if (!(skip & 128u)) { f32x4 a1[2], a2[2]; RK_ZERO(a1); RK_ZERO(a2);
          { Frag f1, f2; ldf(f1, SL(5), SL(15), qb, pb0, fr, kq); ldf(f2, SL(7), SL(15), qb, pb0, fr, kq); RK_LOADED(); mmf(f1, a1); mmf(f2, a2); }
#pragma unroll
          for (int c = 0; c < 2; ++c) { const int p = 16 * (pb0 + c) + fr; st4(SL(2), p, q0, a1[c]); st4(SL(4), p, q0, a2[c]); } }
        if (!(skip & 2048u)) RK_BAR();
        if (!(skip & 128u)) { f32x4 a1[2], a2[2], a3[2], a4[2]; RK_ZERO(a1); RK_ZERO(a2); RK_ZERO(a3); RK_ZERO(a4);
          f32x4 i1[2], i2[2], i4[2];
          { Frag f1, f2, f3, f4; ldf(f1, SL(8), SL(2), qb, pb0, fr, kq); ldf(f2, SL(8), SL(4), qb, pb0, fr, kq); ldf(f3, SL(6), SL(2), qb, pb0, fr, kq); ldf(f4, SL(6), SL(4), qb, pb0, fr, kq);
#pragma unroll
            for (int c = 0; c < 2; ++c) { const int p = 16 * (pb0 + c) + fr; i1[c] = ld4(SL(12), p, q0); i2[c] = ld4(SL(14), p, q0); i4[c] = ld4(SL(3), p, q0); }
            RK_LOADED(); mmf(f1, a1); mmf(f2, a2); mmf(f3, a3); mmf(f4, a4); }
#pragma unroll
          for (int c = 0; c < 2; ++c) { const int p = 16 * (pb0 + c) + fr;
              a1[c] = i1[c] - a1[c]; a2[c] = i2[c] - a2[c]; a4[c] = i4[c] - a4[c];
#pragma unroll
              for (int x = 0; x < 4; ++x) a3[c][x] = ((q0 + x == p) ? GAM[p] : 0.0f) - a3[c][x];
              st4(SL(12), p, q0, a1[c]); st4(SL(14), p, q0, a2[c]); st4(SL(9), p, q0, a3[c]); st4(SL(3), p, q0, a4[c]); } }
        if (!(skip & 2048u)) RK_BAR();
        f32x4 sn[2]; RK_ZERO(sn);
        if (!(skip & 256u)) { f32x4 ay[2]; RK_ZERO(ay);
          { Frag f1, f2, f3, f4; ldf(f1, SL(12), SS, qb, pb0, fr, kq); ldf(f2, SL(14), SL(13), qb, pb0, fr, kq); ldf(f3, SS, SL(9), qb, pb0, fr, kq); ldf(f4, SL(13), SL(3), qb, pb0, fr, kq);
            RK_LOADED(); mmf(f1, ay); mmf(f2, ay); mmf(f3, sn); mmf(f4, sn); }
#pragma unroll
          for (int c = 0; c < 2; ++c) *(LAS f32x4*)(F0 + (16 * (pb0 + c) + fr) * LDF + q0) = ay[c]; }
        if (!(skip & 2048u)) RK_BAR();
#pragma unroll
        for (int c = 0; c < 2; ++c) st4(SS, 16 * (pb0 + c) + fr, q0, sn[c]);
        if (!(skip & 512u)) {
            const float bsl = sum8(BP[(lane & 7) * 64 + 8 * wave + (lane >> 3)]);
#pragma unroll 4
            for (int i8 = 0; i8 < 8; ++i8) { const int t = 8 * wave + i8;
                const float y = F0[t * LDF + lane];
                const float s1 = wave_sum(y), s2 = wave_sum(y * y);
                const float mean = s1 * (1.f / 64.f), var = fmaxf(s2 * (1.f / 64.f) - mean * mean, 0.f);
                const float yn = (y - mean) * __builtin_amdgcn_rsqf(var + 64e-5f) * gnw + gnb;
                const float bs = __builtin_bit_cast(float, __builtin_amdgcn_readlane(__builtin_bit_cast(int, bsl), 8 * i8));
                const float vv = bf2f(SL(13)[AD(lane, t)]), gg = bf2f(SG[AD(t, lane)]);
                if (!(skip & 0x80000000u)) mix[(rowb + t0 + t) * DM + 512 + h * 64 + lane] = (bf16_t)f2bf((yn + bs * vv) * gg); } }
    }
#undef RK_PREFETCH
#undef SL
#undef SLF
#undef c_w0
#undef c_a0
#undef c_kk
#undef c_ka
#undef c_rk
}

__device__ __forceinline__ void phase_merge(const bf16_t* opat, const float* lse, bf16_t* mix, int tid, int part, int nparts) {
    const size_t total = (size_t)MTOK * 64, stride = (size_t)nparts * NTHR;
    for (size_t idx = (size_t)part * NTHR + tid; idx < total; idx += stride) {
        const size_t tok = idx >> 6; const int hd = (int)(idx & 63), h = hd >> 3, ch = hd & 7;
        const float l0 = lse[(0 * (size_t)MTOK + tok) * NH + h], l1 = lse[(1 * (size_t)MTOK + tok) * NH + h], l2 = lse[(2 * (size_t)MTOK + tok) * NH + h];
        const float m = fmaxf(l0, fmaxf(l1, l2)); float w0 = __expf(l0 - m), w1 = __expf(l1 - m), w2 = __expf(l2 - m); const float inv = 1.0f / (w0 + w1 + w2); w0 *= inv; w1 *= inv; w2 *= inv;
        const size_t off = tok * 512 + h * 64 + ch * 8;
        const u32x4 a0 = *(const u32x4*)(opat + off), a1 = *(const u32x4*)(opat + (size_t)MTOK * 512 + off), a2 = *(const u32x4*)(opat + 2 * (size_t)MTOK * 512 + off);
        u32x4 o;
#pragma unroll
        for (int q = 0; q < 4; ++q) o[q] = pk2(w0 * bflo(a0[q]) + w1 * bflo(a1[q]) + w2 * bflo(a2[q]), w0 * bfhi(a0[q]) + w1 * bfhi(a1[q]) + w2 * bfhi(a2[q]));
        *(u32x4*)(mix + tok * DM + h * 64 + ch * 8) = o;
    }
}

constexpr int RT_WROW = 520;
constexpr int RT_WTL = 32 * RT_WROW * 2, RT_P = 2 * RT_WTL, RT_RS = RT_P + 128 * 33 * 4;
__device__ __forceinline__ void phase_route(int slab, const Args& a, LAS unsigned char* lds, int tid, const int dry = 0) {
    const int lane = tid & 63, wave = __builtin_amdgcn_readfirstlane(tid >> 6), fr = lane & 15, kq = lane >> 4;
    LAS bf16_t* WTH = (LAS bf16_t*)lds; LAS bf16_t* WTL = (LAS bf16_t*)(lds + RT_WTL);
    LAS float* P = (LAS float*)(lds + RT_P); LAS float* RS = (LAS float*)(lds + RT_RS);
    LAS int* lcnt = (LAS int*)(lds + MISC_OFF); LAS int* gbase = lcnt + 32;
    const float* h = a.out; bf16_t* XN = (bf16_t*)(a.ws + WS_XN2);
    unsigned* cnt = (unsigned*)(a.ws + WS_CTL) + CW_CNT + slab * 32 * 16;
    unsigned* list = (unsigned*)(a.ws + WS_LIST) + (size_t)slab * NE * LCAP; unsigned* tokinfo = (unsigned*)(a.ws + WS_GLIST) + (size_t)slab * SLABT * 8;
    const float* wr = a.in[I_WR]; const float* gf = a.in[I_GFFN]; const float* br = a.in[I_BR];
    for (int batch = blockIdx.x; batch < SLABT / 128; batch += gridDim.x) {
        const int row0 = slab * SLABT + batch * 128;
        const float* hrow = h + (size_t)(row0 + wave * 16 + fr) * DM + 8 * kq;
        f32x4 acc0 = {0.f, 0.f, 0.f, 0.f}, acc1 = {0.f, 0.f, 0.f, 0.f}; float ss = 0.f;
        if (tid < 32) lcnt[tid] = 0;
#pragma unroll 1
        for (int kh = 0; kh < 2; ++kh) {
            __syncthreads();
            for (int i = tid; i < 512 * 32; i += NTHR) { const int kk = i >> 5, e = i & 31; const float v = wr[(kh * 512 + kk) * 32 + e] * gf[kh * 512 + kk];
                const unsigned hb = f2bf(v); const unsigned lb = f2bf(v - bf2f((unsigned short)hb)); WTH[e * RT_WROW + kk] = (bf16_t)hb; WTL[e * RT_WROW + kk] = (bf16_t)lb; }
            __syncthreads();
#pragma unroll 8
            for (int ks = 0; ks < 16; ++ks) {
                const f32x4 x0 = *(const f32x4*)(hrow + kh * 512 + 32 * ks), x1 = *(const f32x4*)(hrow + kh * 512 + 32 * ks + 4);
                ss += (x0[0] * x0[0] + x0[1] * x0[1]) + (x0[2] * x0[2] + x0[3] * x0[3]) + (x1[0] * x1[0] + x1[1] * x1[1]) + (x1[2] * x1[2] + x1[3] * x1[3]);
                float xv[8] = {x0[0], x0[1], x0[2], x0[3], x1[0], x1[1], x1[2], x1[3]}; unsigned hb[8], lb[8];
#pragma unroll
                for (int q = 0; q < 8; ++q) { hb[q] = f2bf(xv[q]); lb[q] = f2bf(xv[q] - bf2f((unsigned short)hb[q])); }
                u32x4 ah, al;
#pragma unroll
                for (int q = 0; q < 4; ++q) { ah[q] = hb[2 * q] | (hb[2 * q + 1] << 16); al[q] = lb[2 * q] | (lb[2 * q + 1] << 16); }
                const bf16x8 Ah = __builtin_bit_cast(bf16x8, ah), Al = __builtin_bit_cast(bf16x8, al);
                const bf16x8 Bh0 = *(const LAS bf16x8*)(WTH + fr * RT_WROW + 32 * ks + 8 * kq), Bl0 = *(const LAS bf16x8*)(WTL + fr * RT_WROW + 32 * ks + 8 * kq);
                const bf16x8 Bh1 = *(const LAS bf16x8*)(WTH + (16 + fr) * RT_WROW + 32 * ks + 8 * kq), Bl1 = *(const LAS bf16x8*)(WTL + (16 + fr) * RT_WROW + 32 * ks + 8 * kq);
                acc0 = __builtin_amdgcn_mfma_f32_16x16x32_bf16(Ah, Bh0, acc0, 0, 0, 0); acc0 = __builtin_amdgcn_mfma_f32_16x16x32_bf16(Ah, Bl0, acc0, 0, 0, 0); acc0 = __builtin_amdgcn_mfma_f32_16x16x32_bf16(Al, Bh0, acc0, 0, 0, 0);
                acc1 = __builtin_amdgcn_mfma_f32_16x16x32_bf16(Ah, Bh1, acc1, 0, 0, 0); acc1 = __builtin_amdgcn_mfma_f32_16x16x32_bf16(Ah, Bl1, acc1, 0, 0, 0); acc1 = __builtin_amdgcn_mfma_f32_16x16x32_bf16(Al, Bh1, acc1, 0, 0, 0);
            }
        }
        ss += __shfl_xor(ss, 16); ss += __shfl_xor(ss, 32);
        if (kq == 0) RS[wave * 16 + fr] = 1.0f / sqrtf(ss * (1.f / DM) + 1e-5f);
#pragma unroll
        for (int r = 0; r < 4; ++r) { P[(wave * 16 + kq * 4 + r) * 33 + fr] = acc0[r]; P[(wave * 16 + kq * 4 + r) * 33 + 16 + fr] = acc1[r]; }
        __syncthreads();
        int te[4] = {0, 0, 0, 0}; float tg[4] = {0.f, 0.f, 0.f, 0.f}; int lp[4] = {0, 0, 0, 0};
        if (tid < 128) { const float rs = RS[tid]; float tv[4] = {-INFINITY, -INFINITY, -INFINITY, -INFINITY};
#pragma unroll 1
            for (int e = 0; e < 32; ++e) { const float v = P[tid * 33 + e] * rs + br[e];
                if (v > tv[3]) { if (v > tv[0]) { tv[3] = tv[2]; te[3] = te[2]; tv[2] = tv[1]; te[2] = te[1]; tv[1] = tv[0]; te[1] = te[0]; tv[0] = v; te[0] = e; }
                    else if (v > tv[1]) { tv[3] = tv[2]; te[3] = te[2]; tv[2] = tv[1]; te[2] = te[1]; tv[1] = v; te[1] = e; }
                    else if (v > tv[2]) { tv[3] = tv[2]; te[3] = te[2]; tv[2] = v; te[2] = e; }
                    else { tv[3] = v; te[3] = e; } } }
            const float e1 = __expf(tv[1] - tv[0]), e2 = __expf(tv[2] - tv[0]), e3 = __expf(tv[3] - tv[0]); const float inv = 1.0f / (1.0f + e1 + e2 + e3);
            tg[0] = inv; tg[1] = e1 * inv; tg[2] = e2 * inv; tg[3] = e3 * inv;
#pragma unroll
            for (int k = 0; k < 4; ++k) lp[k] = atomicAdd((int*)(lcnt + te[k]), 1); }
        __syncthreads();
        if (tid < 32) gbase[tid] = dry ? 0 : (int)atomicAdd(cnt + tid * 16, (unsigned)lcnt[tid]);
        __syncthreads();
        if (tid < 128 && !dry) {
#pragma unroll
            for (int k = 0; k < 4; ++k) { const int pos = gbase[te[k]] + lp[k]; list[(size_t)te[k] * LCAP + pos] = (unsigned)((batch * 128 + tid) * 4 + k); lp[k] = pos; }
            u32x4* ti = (u32x4*)(tokinfo + (size_t)(batch * 128 + tid) * 8);
            ti[0] = (u32x4){((unsigned)te[0] << 24) | (unsigned)lp[0], ((unsigned)te[1] << 24) | (unsigned)lp[1], ((unsigned)te[2] << 24) | (unsigned)lp[2], ((unsigned)te[3] << 24) | (unsigned)lp[3]};
            ti[1] = (u32x4){__builtin_bit_cast(unsigned, tg[0]), __builtin_bit_cast(unsigned, tg[1]), __builtin_bit_cast(unsigned, tg[2]), __builtin_bit_cast(unsigned, tg[3])}; }
#pragma unroll 4
        for (int r = 0; r < 16; ++r) { const int rw = wave * 16 + r; const float rs = RS[rw]; const f32x4* xr = (const f32x4*)(h + (size_t)(row0 + rw) * DM) + lane;
#if MOE_FP8_GU
            unsigned* o4 = (unsigned*)((unsigned char*)XN + (size_t)(row0 + rw) * DM) + lane;
#pragma unroll
            for (int j = 0; j < 4; ++j) { const f32x4 v = xr[64 * j]; o4[64 * j] = pk4_fp8(v.x * rs, v.y * rs, v.z * rs, v.w * rs); } }
#else
            unsigned long long* o8 = (unsigned long long*)(XN + (size_t)(row0 + rw) * DM) + lane;
#pragma unroll
            for (int j = 0; j < 4; ++j) { const f32x4 v = xr[64 * j]; o8[64 * j] = (unsigned long long)pk2(v.x * rs, v.y * rs) | ((unsigned long long)pk2(v.z * rs, v.w * rs) << 32); } }
#endif
        __syncthreads();
    }
}
__device__ __forceinline__ void moe_tables(int slab, const Args& a, LAS unsigned char* lds, int nNt, int tid) {
    LAS int* tab = (LAS int*)(lds + MISC_OFF);
    const unsigned* cnt = (const unsigned*)(a.ws + WS_CTL) + CW_CNT + slab * 32 * 16;
    if (tid == 0) { int tp = 0, rb = 0;
        for (int e = 0; e < NE; ++e) { const int c = (int)__hip_atomic_load(cnt + e * 16, __ATOMIC_RELAXED, __HIP_MEMORY_SCOPE_AGENT); const int mt = (c + 255) >> 8; tab[e] = tp; tab[64 + e] = c; tab[128 + e] = rb; tp += mt * nNt; rb += mt * 256; }
        tab[32] = tp; }
    __syncthreads();
}
__device__ __forceinline__ void phase_final(int slab, const Args& a, LAS unsigned char* lds, int tid, const int dry = 0) {
    const int lane = tid & 63, wave = __builtin_amdgcn_readfirstlane(tid >> 6);
    moe_tables(slab, a, lds, 4, tid);
    const LAS int* tab = (const LAS int*)(lds + MISC_OFF);
    const unsigned char* EO = (const unsigned char*)(a.ws + WS_EOUT); const float* gfin = a.in[I_GFIN];
    constexpr int EB = EOUT_FP8 ? 1 : 2;
    const unsigned* tokinfo = (const unsigned*)(a.ws + WS_GLIST) + (size_t)slab * SLABT * 8;
    const int gw = blockIdx.x * NWAVES + wave, NGW = gridDim.x * NWAVES;
    f32x4 gf[4];
#pragma unroll
    for (int j = 0; j < 4; ++j) gf[j] = *((const f32x4*)gfin + lane + 64 * j);
    u32x4 inf[2], gin[2];
#pragma unroll
    for (int r = 0; r < 2; ++r) { const int rl = gw + r * NGW; const int rc = rl < SLABT ? rl : 0; inf[r] = *(const u32x4*)(tokinfo + (size_t)rc * 8); gin[r] = *(const u32x4*)(tokinfo + (size_t)rc * 8 + 4); }
    for (int rl0 = gw; rl0 < SLABT; rl0 += 2 * NGW) {
        const unsigned char* er[2][4]; float gk[2][4];
#pragma unroll
        for (int r = 0; r < 2; ++r)
#pragma unroll
            for (int k = 0; k < 4; ++k) { const unsigned w = __builtin_amdgcn_readfirstlane(inf[r][k]); er[r][k] = EO + (size_t)(tab[128 + (w >> 24)] + (int)(w & 0xffffffu)) * DM * EB; gk[r][k] = __builtin_bit_cast(float, __builtin_amdgcn_readfirstlane(gin[r][k])); }
#if EOUT_FP8
        f32x4 v[2][4]; unsigned ew[2][4][4];
#else
        f32x4 v[2][4]; u32x2 ew[2][4][4];
#endif
#pragma unroll
        for (int r = 0; r < 2; ++r) { const int rl = rl0 + r * NGW; const int rc = rl < SLABT ? rl : rl0; const float* hr = a.out + (size_t)(slab * SLABT + rc) * DM;
#pragma unroll
            for (int j = 0; j < 4; ++j) { v[r][j] = *((const f32x4*)hr + lane + 64 * j);
#pragma unroll
#if EOUT_FP8
                for (int k = 0; k < 4; ++k) ew[r][j][k] = *((const unsigned*)er[r][k] + lane + 64 * j); } }
#else
                for (int k = 0; k < 4; ++k) ew[r][j][k] = *((const u32x2*)er[r][k] + lane + 64 * j); } }
#endif
#pragma unroll
        for (int r = 0; r < 2; ++r) { const int rn = rl0 + (2 + r) * NGW; const int rc = rn < SLABT ? rn : 0; inf[r] = *(const u32x4*)(tokinfo + (size_t)rc * 8); gin[r] = *(const u32x4*)(tokinfo + (size_t)rc * 8 + 4); }
#pragma unroll
        for (int r = 0; r < 2; ++r) { const int rl = rl0 + r * NGW; float ss = 0.f;
#pragma unroll
            for (int j = 0; j < 4; ++j) {
#pragma unroll
#if EOUT_FP8
                for (int k = 0; k < 4; ++k) { const int w = (int)ew[r][j][k]; const f32x2 lo = __builtin_amdgcn_cvt_pk_f32_fp8(w, false), hi2 = __builtin_amdgcn_cvt_pk_f32_fp8(w, true);
                    v[r][j].x += gk[r][k] * lo[0]; v[r][j].y += gk[r][k] * lo[1]; v[r][j].z += gk[r][k] * hi2[0]; v[r][j].w += gk[r][k] * hi2[1]; }
#else
                for (int k = 0; k < 4; ++k) { const u32x2 w = ew[r][j][k]; v[r][j].x += gk[r][k] * bflo(w.x); v[r][j].y += gk[r][k] * bfhi(w.x); v[r][j].z += gk[r][k] * bflo(w.y); v[r][j].w += gk[r][k] * bfhi(w.y); }
#endif
                ss += (v[r][j].x * v[r][j].x + v[r][j].y * v[r][j].y) + (v[r][j].z * v[r][j].z + v[r][j].w * v[r][j].w); }
            const float rs = 1.0f / sqrtf(wave_sum(ss) * (1.f / DM) + 1e-5f);
            if (rl < SLABT) { float* hr = a.out + (size_t)(slab * SLABT + rl) * DM;
#pragma unroll
                for (int j = 0; j < 4; ++j) { const f32x4 o = v[r][j] * rs * gf[j]; if (!dry) *((f32x4*)hr + lane + 64 * j) = o; else if (o[0] == 1.2345e30f) hr[0] = 0.f; } } }
    }
}


#define XB_TMO      128
#define XB_XCNT(j)  (256  + 64 * (j))
#define XB_XSUB(j)  (1280 + 64 * (j))
#define XB_XGEN(j)  (2304 + 64 * (j))
#define XB_TOP      3328
#define XB_TOPGEN   3392
#define XCD_BAR_WORDS 3456
#define XB_SPIN_CAP (1u << 22)
__device__ __forceinline__ unsigned xb_ld(unsigned* p)              { return __hip_atomic_load(p, __ATOMIC_RELAXED, __HIP_MEMORY_SCOPE_AGENT); }
__device__ __forceinline__ unsigned xb_add(unsigned* p, unsigned v) { return __hip_atomic_fetch_add(p, v, __ATOMIC_RELAXED, __HIP_MEMORY_SCOPE_AGENT); }
__device__ __forceinline__ unsigned xb_xcc_id() { return (unsigned)__builtin_amdgcn_s_getreg((3 << 11) | 20) & 0xFu; }
#define XB_SPIN(cond, bar) do { unsigned _sp = 0; while (cond) { __builtin_amdgcn_s_sleep(1); \
    if ((++_sp & 255u) == 0u) { if (xb_ld(&(bar)[XB_TMO])) break; if (_sp > XB_SPIN_CAP) { atomicAdd(&(bar)[XB_TMO], 1u); break; } } } } while (0)
struct XcdBarrier { unsigned* bar; unsigned x; volatile LAS unsigned* st; };
__device__ __forceinline__ XcdBarrier xcd_barrier_post(unsigned* bar, volatile LAS unsigned* st) {
    XcdBarrier b; b.bar = bar; b.x = xb_xcc_id(); b.st = st;
    if (threadIdx.x == 0) (void)xb_add(&bar[XB_XCNT(b.x)], 1u);
    return b;
}
__device__ __forceinline__ void xcd_barrier_complete(unsigned* bar, unsigned x, unsigned& nloc, unsigned& nx) {
    const unsigned G = gridDim.x * gridDim.y * gridDim.z;
    unsigned sum, cnt, mine, sp = 0u;
    for (;;) {
        sum = 0u; cnt = 0u; mine = 0u;
#pragma unroll
        for (unsigned j = 0; j < 16; ++j) { const unsigned c = xb_ld(&bar[XB_XCNT(j)]); sum += c; cnt += (c > 0u) ? 1u : 0u; mine = (j == x) ? c : mine; }
        if (sum == G) break;
        __builtin_amdgcn_s_sleep(1);
        if ((++sp & 255u) == 0u) { if (xb_ld(&bar[XB_TMO])) break; if (sp > XB_SPIN_CAP) { atomicAdd(&bar[XB_TMO], 1u); break; } }
    }
    nloc = mine > 0u ? mine : 1u; nx = cnt > 0u ? cnt : 1u;
}
__device__ __forceinline__ void xcd_barrier(const XcdBarrier& b) {
    asm volatile("s_waitcnt vmcnt(0)" ::: "memory");
    __syncthreads();
    if (threadIdx.x == 0) {
        unsigned* bar = b.bar;
        __builtin_amdgcn_s_waitcnt(0);
        unsigned nloc = b.st[0], nx = b.st[1];
        if (nloc == 0u) { xcd_barrier_complete(bar, b.x, nloc, nx); b.st[0] = nloc; b.st[1] = nx; }
        const unsigned old = xb_add(&bar[XB_XSUB(b.x)], 1u);
        const unsigned gen = old / nloc;
        if (old + 1u == (gen + 1u) * nloc) {
            __builtin_amdgcn_fence(__ATOMIC_RELEASE, "agent");
            asm volatile("s_waitcnt vmcnt(0)" ::: "memory");
            const unsigned og = xb_add(&bar[XB_TOP], 1u);
            const unsigned tg = og / nx;
            if (og + 1u == (tg + 1u) * nx) xb_add(&bar[XB_TOPGEN], 1u);
            else XB_SPIN(xb_ld(&bar[XB_TOPGEN]) == tg, bar);
            __builtin_amdgcn_fence(__ATOMIC_ACQUIRE, "agent");
            xb_add(&bar[XB_XGEN(b.x)], 1u);
            asm volatile("s_waitcnt vmcnt(0)" ::: "memory");
        } else {
            XB_SPIN(xb_ld(&bar[XB_XGEN(b.x)]) == gen, bar);
            __builtin_amdgcn_fence(__ATOMIC_ACQUIRE, "agent");
            asm volatile("s_waitcnt vmcnt(0)" ::: "memory");
        }
    }
    __syncthreads();
}

__device__ __forceinline__ void sub_barrier(unsigned* ctr, unsigned n) {
    asm volatile("s_waitcnt vmcnt(0)" ::: "memory");
    __syncthreads();
    if (threadIdx.x == 0) {
        __builtin_amdgcn_fence(__ATOMIC_RELEASE, "agent");
        asm volatile("s_waitcnt vmcnt(0)" ::: "memory");
        xb_add(ctr, 1u);
        unsigned sp = 0; while (xb_ld(ctr) < n) { __builtin_amdgcn_s_sleep(2); if (++sp > (1u << 24)) break; }
        __builtin_amdgcn_fence(__ATOMIC_ACQUIRE, "agent");
        asm volatile("s_waitcnt vmcnt(0)" ::: "memory");
    }
    __syncthreads();
}

constexpr int NPHASE = 12;
__global__ void __launch_bounds__(NTHR, 2) mega_fwd(Args args) {
    extern __shared__ __attribute__((aligned(16))) unsigned char lds_raw[];
    LAS unsigned char* lds = (LAS unsigned char*)lds_raw;
    const int tid0 = threadIdx.x;
#define OT() ({ int t_ = tid0; asm volatile("" : "+v"(t_)); t_; })
    const int G = gridDim.x, bx = blockIdx.x;
    const int vcu = (G % 8 == 0) ? (bx % 8) * (G / 8) + bx / 8 : bx;
#define KA() args
    unsigned char* ws = args.ws;
    bf16_t* Wt_in = (bf16_t*)(ws + WS_WIN); bf16_t* Wt_out = (bf16_t*)(ws + WS_WOUT); bf16_t* Wt_gu = (bf16_t*)(ws + WS_WGU); bf16_t* Wt_dn = (bf16_t*)(ws + WS_WDN);
    bf16_t* XN = (bf16_t*)(ws + WS_XN); bf16_t* PROJ = (bf16_t*)(ws + WS_PROJ); bf16_t* MIX = (bf16_t*)(ws + WS_MIX);
    bf16_t* ACT = (bf16_t*)(ws + WS_ACT); bf16_t* EOUT = (bf16_t*)(ws + WS_EOUT);
    float* LSE = (float*)(ws + WS_LSE); bf16_t* OPAT = (bf16_t*)KA().out;
    const int lo = KA().ph_lo, hi = KA().ph_hi;
#if MK_MULTI
#define GRID_SYNC() do { } while (0)
#elif USE_CG_SYNC
    cg::grid_group grid = cg::this_grid();
#define GRID_SYNC() grid.sync()
#else
    { volatile LAS unsigned* stw = (volatile LAS unsigned*)(lds + XBST_OFF); if (tid0 < 2) stw[tid0] = 0u; }
    __syncthreads();
    const XcdBarrier xbar = xcd_barrier_post((unsigned*)(ws + WS_CTL) + CW_BAR, (volatile LAS unsigned*)(lds + XBST_OFF));
#define GRID_SYNC() xcd_barrier(xbar)
#endif
#ifndef PHM
#define PHM 0xFFFF
#endif
#define IN(k) (((PHM >> (k)) & 1) && lo <= (k) && (k) < hi)
#define SEAM(k) do { if (IN(k) && IN((k) + 1)) { GRID_SYNC(); } } while (0)
#ifndef PROBE_DUP
#define PROBE_DUP -1
#endif
#ifndef PROBE_SUB
#define PROBE_SUB 0
#endif
#ifndef PROBE_MASK
#define PROBE_MASK 0
#endif
#define REPS(k) for (int rep_ = 0; rep_ < ((PROBE_DUP == (k)) ? 2 : 1); ++rep_, (rep_ < ((PROBE_DUP == (k)) ? 2 : 1) ? (GRID_SYNC(), 0) : 0))

    if (IN(0)) REPS(0) { const int t_ = OT(); phase_prologue(KA(), lds, __builtin_amdgcn_readfirstlane(t_ >> 6), t_ & 63); }
    SEAM(0);
    if (IN(1)) REPS(1) { DenseSched S; S.o.init(MTOK, INW, G, bx); EpiProj E{PROJ}; pg8::gemm_phase<EpiProj, DenseSched>(lds, XN, Wt_in, DM, S, E); }
    SEAM(1);
    if (IN(2)) REPS(2) {
        const int nR = (G >= 256) ? 128 : G / 2;
#ifndef NO_RWKV
        if (bx < nR && !(rep_ == 1 && (PROBE_SUB & 2))) { for (int hd = bx; hd < NB * NH; hd += nR) RWKV_FN(hd >> 3, hd & 7, KA(), PROJ, MIX, lds, OT(), (rep_ == 1) ? (0x80000000u | (unsigned)PROBE_MASK) : 0u); }
#endif
#ifndef NO_ATTN
        if (bx >= nR && !(rep_ == 1 && (PROBE_SUB & 1))) { for (int T = bx - nR; T < 3 * 2048; T += G - nR) attn_task(T, PROJ, OPAT, LSE, lds, OT());
            if (rep_ == 0) {
#if !MK_MULTI
                sub_barrier((unsigned*)(ws + WS_CTL) + CW_SUB, (unsigned)(G - nR));
                for (int r2_ = 0; r2_ < ((PROBE_DUP == 9) ? 3 : 1); ++r2_)
                phase_merge(OPAT, LSE, MIX, OT(), bx - nR, G - nR);
#endif
                for (int r2_ = 0; r2_ < ((PROBE_DUP == 3) ? 2 : 1); ++r2_) { const int t_ = OT(); expert_weight_items(KA(), lds, __builtin_amdgcn_readfirstlane(t_ >> 6), t_ & 63, bx - nR, G - nR); } } }
#endif
    }
    SEAM(2);
#if MK_MULTI
    if (IN(3)) REPS(3) { phase_merge(OPAT, LSE, MIX, OT(), bx, G); }
#endif
    if (IN(4)) REPS(4) { DenseSched S; S.o.init(MTOK, DM, G, bx); const Args& A_ = KA(); EpiResid E{A_.in[I_X], A_.out}; pg8::gemm_phase<EpiResid, DenseSched>(lds, MIX, Wt_out, DM, S, E); }
    SEAM(4);
#pragma unroll 1
    for (int slab = 0; slab < NSLAB; ++slab) {
        const int p0 = 5 + 3 * slab;
        unsigned* list = (unsigned*)(ws + WS_LIST) + (size_t)slab * NE * LCAP; float* glist = (float*)(ws + WS_GLIST) + (size_t)slab * NE * LCAP;
        if (slab == 0) { if (IN(5)) { if (PROBE_DUP == 5) { phase_route(0, KA(), lds, OT(), 1); GRID_SYNC(); } phase_route(0, KA(), lds, OT()); } SEAM(5); }
        if (IN(p0 + 1)) REPS(6) { const Args& A_ = KA(); moe_tables(slab, A_, lds, 8, OT());
            constexpr int EB = MOE_FP8_GU ? 1 : 2;
            MoeSched S{(const LAS int*)(lds + MISC_OFF), 8, G, vcu, list, (unsigned)(slab * SLABT), (rep_ == 1 && (PROBE_MASK & 2)) ? 0 : 1, (size_t)2 * DFF * DM * EB, (size_t)256 * DM * EB};
            EpiSwiglu E{ACT, A_.in[I_BGUP], (rep_ == 1) ? (PROBE_MASK | 4) : 0}; pg8::gemm_phase<EpiSwiglu, MoeSched, MOE_FP8_GU != 0>(lds, (const bf16_t*)(ws + WS_XN2), Wt_gu, DM * EB / 2, S, E); }
        SEAM(p0 + 1);
        if (IN(p0 + 2)) REPS(7) { const Args& A_ = KA(); moe_tables(slab, A_, lds, 4, OT());
            constexpr int EB = MOE_FP8_DN ? 1 : 2;
            MoeSched S{(const LAS int*)(lds + MISC_OFF), 4, G, vcu, list, 0u, 0, (size_t)DM * DFF * EB, (size_t)256 * DFF * EB};
            EpiDown E{EOUT, A_.in[I_BDN], (rep_ == 1) ? PROBE_MASK : 0}; pg8::gemm_phase<EpiDown, MoeSched, MOE_FP8_DN != 0>(lds, ACT, Wt_dn, DFF * EB / 2, S, E); }
        SEAM(p0 + 2);
        if (IN(p0 + 3)) { const int t_ = OT(); if (PROBE_DUP == 8) { phase_final(slab, KA(), lds, t_, 1); GRID_SYNC(); } phase_final(slab, KA(), lds, t_); if (slab + 1 < NSLAB) { __syncthreads(); phase_route(slab + 1, KA(), lds, OT()); } }
        if (slab + 1 < NSLAB) SEAM(p0 + 3);
    }
#undef IN
#undef REPS
#undef SEAM
#undef GRID_SYNC
#undef KA
#undef OT
}

extern "C" void kernel_launch(void* const* d_in, const int* in_sizes, int n_in, void* d_out, int out_size, void* d_ws, size_t ws_size, hipStream_t stream) {
    static int grid = 0;
    if (grid == 0) {
        if (n_in != 23 || in_sizes[0] != MTOK * DM || out_size != MTOK * DM || ws_size < WS_NEED) { fprintf(stderr, "kernel_launch: unexpected shapes (n_in %d, in0 %d, out %d, ws %zu)\n", n_in, n_in > 0 ? in_sizes[0] : -1, out_size, ws_size); grid = -1; return; }
        int dev = 0, cus = 0, per_cu = 0;
        if (hipGetDevice(&dev) != hipSuccess || hipDeviceGetAttribute(&cus, hipDeviceAttributeMultiprocessorCount, dev) != hipSuccess) { grid = -1; return; }
        if (hipFuncSetAttribute((const void*)mega_fwd, hipFuncAttributeMaxDynamicSharedMemorySize, LDS_BYTES) != hipSuccess) { fprintf(stderr, "kernel_launch: hipFuncSetAttribute failed\n"); grid = -1; return; }
        if (hipOccupancyMaxActiveBlocksPerMultiprocessor(&per_cu, (const void*)mega_fwd, NTHR, LDS_BYTES) != hipSuccess || per_cu < 1) { fprintf(stderr, "kernel_launch: occupancy query says %d\n", per_cu); per_cu = 1; }
        (void)hipGetLastError();
        grid = cus;
    }
    if (grid < 0) return;
    (void)hipMemsetAsync((char*)d_ws + WS_CTL, 0, CTL_BYTES, stream);
    Args a{};
    for (int i = 0; i < 23; ++i) a.in[i] = (const float*)d_in[i];
    a.out = (float*)d_out; a.ws = (unsigned char*)d_ws;
#if MK_MULTI
    for (int p = 0; p < NPHASE; ++p) { a.ph_lo = p; a.ph_hi = p + 1; hipLaunchKernelGGL(mega_fwd, dim3(grid), dim3(NTHR), LDS_BYTES, stream, a); }
#else
    a.ph_lo = 0; a.ph_hi = NPHASE;
    void* kargs[] = {&a};
    hipError_t e = hipLaunchCooperativeKernel((const void*)mega_fwd, dim3(grid), dim3(NTHR), kargs, LDS_BYTES, stream);
    if (e != hipSuccess) fprintf(stderr, "kernel_launch: cooperative launch failed: %s (grid %d)\n", hipGetErrorString(e), grid);
#endif
}
```

```cpp
#include <hip/hip_runtime.h>
#include <hip/hip_cooperative_groups.h>
#include <cstdio>
#include <cstdint>
namespace cg = cooperative_groups;

#ifndef MOE_FP8_GU
#define MOE_FP8_GU 1
#endif
#ifndef MOE_FP8_DN
#define MOE_FP8_DN 1
#endif
#ifndef EOUT_FP8
#define EOUT_FP8 1
#endif
#ifndef RWKV_CHUNKED
#define RWKV_CHUNKED 1
#endif
#if RWKV_CHUNKED
#define RWKV_FN rwkv_head_chunked
#else
#define RWKV_FN rwkv_head
#endif
#ifndef USE_CG_SYNC
#define USE_CG_SYNC 0
#endif
#ifndef MK_MULTI
#define MK_MULTI 0
#endif

#define LAS __attribute__((address_space(3)))
typedef unsigned short bf16_t;
typedef short bf16x8 __attribute__((ext_vector_type(8)));
typedef short s16x4 __attribute__((ext_vector_type(4)));
typedef float f32x2 __attribute__((ext_vector_type(2)));
typedef float f32x4 __attribute__((ext_vector_type(4)));
typedef float f32x16 __attribute__((ext_vector_type(16)));
typedef unsigned u32x4 __attribute__((ext_vector_type(4)));
typedef unsigned u32x2 __attribute__((ext_vector_type(2)));
typedef int i32x4 __attribute__((ext_vector_type(4)));
typedef int i32x8 __attribute__((ext_vector_type(8)));

constexpr int NB = 16, SEQ = 4096, DM = 1024, MTOK = NB * SEQ;
constexpr int INW = 3328, NH = 8, HD = 64;
constexpr int NE = 32, DFF = 1024;
#ifndef MOE_NSLAB
#define MOE_NSLAB 1
#endif
constexpr int NSLAB = MOE_NSLAB, SLABT = MTOK / NSLAB;
constexpr int LCAP = SLABT;
constexpr int ACT_ROWS = SLABT * 4 + NE * 256;
constexpr int NWAVES = 8, NTHR = 512;
constexpr int LDS_BYTES = 163840;
constexpr int GEMM_LDS = 131072, MISC_OFF = 131072, XBST_OFF = LDS_BYTES - 64;

constexpr size_t MiB = 1u << 20;
constexpr size_t WS_CTL = 0, CTL_BYTES = 64 * 1024;
constexpr size_t WS_WIN = 1 * MiB, WS_WOUT = 8 * MiB, WS_WGU = 10 * MiB, WS_WDN = 138 * MiB;
constexpr size_t WS_LIST = 202 * MiB, WS_GLIST = 210 * MiB, WS_LSE = 218 * MiB;
constexpr size_t WS_XN = 224 * MiB, WS_PROJ = 352 * MiB, WS_MIX = 768 * MiB, WS_END = 896 * MiB;
constexpr size_t WS_XN2 = (NSLAB == 1) ? 74 * MiB : WS_XN;
constexpr size_t WS_ACT = (NSLAB == 1) ? 224 * MiB : 352 * MiB, WS_EOUT = (NSLAB == 1) ? 488 * MiB : 624 * MiB;
constexpr size_t WS_NEED = (NSLAB == 1) ? 1016 * MiB : WS_END;
static_assert(WS_ACT + (size_t)ACT_ROWS * DFF * (MOE_FP8_DN ? 1 : 2) <= WS_EOUT && WS_EOUT + (size_t)ACT_ROWS * DM * 2 <= WS_NEED && (NSLAB != 1 || (MOE_FP8_GU && MOE_FP8_DN)), "ws map");
constexpr int CW_CNT = 1024, CW_BAR = 4096, CW_SUB = 8192;

struct Args { const float* in[23]; float* out; unsigned char* ws; int ph_lo, ph_hi; };
enum { I_X = 0, I_GMIX, I_WIN, I_MU, I_W0, I_WDU, I_A0, I_WIU, I_WGU, I_KK, I_KA, I_RK, I_GNW, I_GNB, I_WOUT, I_GFFN, I_WR, I_BR, I_WGUP, I_BGUP, I_WDN, I_BDN, I_GFIN };

typedef __bf16 bf16x2_t __attribute__((ext_vector_type(2)));
__device__ __forceinline__ unsigned pk2(float lo, float hi) { f32x2 v = {lo, hi}; bf16x2_t b = __builtin_convertvector(v, bf16x2_t); return __builtin_bit_cast(unsigned, b); }
__device__ __forceinline__ unsigned f2bf(float f) { return pk2(f, f) & 0xffffu; }
__device__ __forceinline__ float bf2f(unsigned short b) { return __builtin_bit_cast(float, (unsigned)b << 16); }
__device__ __forceinline__ float bflo(unsigned w) { return __builtin_bit_cast(float, w << 16); }
__device__ __forceinline__ float bfhi(unsigned w) { return __builtin_bit_cast(float, w & 0xffff0000u); }
template <int CTRL> __device__ __forceinline__ float dpp_f(float v) { return __builtin_bit_cast(float, __builtin_amdgcn_update_dpp(0, __builtin_bit_cast(int, v), CTRL, 0xF, 0xF, true)); }
__device__ __forceinline__ float sum8(float v) { v += dpp_f<0xB1>(v); v += dpp_f<0x4E>(v); v += dpp_f<0x141>(v); return v; }
template <int CTRL, int RMASK> __device__ __forceinline__ float dpp_rm(float v) { return __builtin_bit_cast(float, __builtin_amdgcn_update_dpp(0, __builtin_bit_cast(int, v), CTRL, RMASK, 0xF, false)); }
__device__ __forceinline__ float scan64(float v) {
    v += dpp_f<0x111>(v); v += dpp_f<0x112>(v); v += dpp_f<0x114>(v); v += dpp_f<0x118>(v);
    v += dpp_rm<0x142, 0xA>(v); v += dpp_rm<0x143, 0xC>(v);
    return v;
}
__device__ __forceinline__ float sum16(float v) { v = sum8(v); v += dpp_f<0x140>(v); return v; }
__device__ __forceinline__ float wave_sum(float v) {
    v = sum16(v);
    const float a = __builtin_bit_cast(float, __builtin_amdgcn_readlane(__builtin_bit_cast(int, v), 0)), b = __builtin_bit_cast(float, __builtin_amdgcn_readlane(__builtin_bit_cast(int, v), 16));
    const float c = __builtin_bit_cast(float, __builtin_amdgcn_readlane(__builtin_bit_cast(int, v), 32)), d = __builtin_bit_cast(float, __builtin_amdgcn_readlane(__builtin_bit_cast(int, v), 48));
    return (a + b) + (c + d);
}
__device__ __forceinline__ float sigmoidf_(float x) { return 1.0f / (1.0f + __expf(-x)); }
__device__ __forceinline__ unsigned pk4_fp8(float a, float b, float c, float d) { int w = 0; w = __builtin_amdgcn_cvt_pk_fp8_f32(a, b, w, false); w = __builtin_amdgcn_cvt_pk_fp8_f32(c, d, w, true); return (unsigned)w; }
#define LDS_WAIT() asm volatile("s_waitcnt lgkmcnt(0)" ::: "memory")

namespace pg8 {
constexpr int BM = 256, BK = 64, HALF = 128, HTB = HALF * BK * 2, NXCD = 8, WGM = 4;
__device__ __forceinline__ int lds_byte(int r, int c) { const int st = (r >> 4) * 2 + (c >> 5), rr = r & 15, cc = c & 31, ob = rr * 64 + cc * 2; return st * 1024 + (ob ^ (((ob >> 9) & 1) << 5)); }
__device__ __forceinline__ void stage_rc(int b, int& R, int& C) { const int st = b / 1024, sb = b % 1024, swz = sb ^ (((sb >> 9) & 1) << 5); R = (st >> 1) * 16 + swz / 64; C = (st & 1) * 32 + (swz % 64) / 2; }
__device__ __forceinline__ int perm32(int rho) { const int n = rho >> 4, i = rho & 15; return 8 * (i >> 2) + 4 * n + (i & 3); }

struct Unit { int pm, pn, e, cnt, rbase; };

struct DenseOrder {
    int nM, nN, nwg, G, c;
    __device__ void init(int M, int N, int G_, int c_) { nM = M / BM; nN = N / BM; nwg = nM * nN; G = G_; c = c_; }
    __device__ bool next(int i, Unit& u) const {
        const long L = (long)i * G + c; if (L >= nwg) return false;
        int wgid = (int)L; { const int q = nwg / NXCD, r = nwg % NXCD, xcd = wgid % NXCD, off = wgid / NXCD; wgid = (xcd < r ? xcd * (q + 1) : r * (q + 1) + (xcd - r) * q) + off; }
        const int nig = WGM * nN, gid = wgid / nig, fm = gid * WGM, gsz = (nM - fm) < WGM ? (nM - fm) : WGM;
        u.pm = fm + ((wgid % nig) % gsz); u.pn = (wgid % nig) / gsz; u.e = 0; u.cnt = 0; u.rbase = 0; return true;
    }
};

__device__ __forceinline__ unsigned cvt_pk_bf16(float lo, float hi) { unsigned r; asm volatile("v_cvt_pk_bf16_f32 %0, %1, %2" : "=v"(r) : "v"(lo), "v"(hi)); return r; }

template <class Epi, class Sched, bool FP8 = false>
__device__ __forceinline__ void gemm_phase(LAS unsigned char* lds, const bf16_t* A, const bf16_t* Bt, const int K, const Sched& S, const Epi& E) {
    int tid = threadIdx.x; asm volatile("" : "+v"(tid));
    const int wid = __builtin_amdgcn_readfirstlane(tid >> 6), lane = tid & 63, wr = wid >> 2, wc = wid & 3, fr = lane & 15, fq = lane >> 4;
    const int nt = K / BK;
    unsigned voffB[2];
#pragma unroll
    for (int i = 0; i < 2; ++i) { int R, C; stage_rc(tid * 16 + i * 8192, R, C); const int Rb = Epi::PERM ? ((R & ~31) + perm32(R & 31)) : R; voffB[i] = (unsigned)(Rb * K + C) * 2u; }
#define PG8_RC(i_) int t2_ = tid; asm volatile("" : "+v"(t2_)); int R_, C_; stage_rc(t2_ * 16 + (i_) * 8192, R_, C_)
    const size_t kstep = (size_t)(BK * 2);
    const size_t hstep = (size_t)HALF * K * 2;
    const unsigned ldsw = (unsigned)wid * 1024u;
    const int aoff = lds_byte(wr * 64 + fr, fq * 8), boff = lds_byte(wc * 32 + fr, fq * 8);
#define PG8_SA(b, h) (((b) * 2 + (h)) * HTB)
#define PG8_SB(b, h) ((4 + (b) * 2 + (h)) * HTB)
#define PG8_STAGE(bufoff, gbase, voff) do { _Pragma("unroll") for (int _i = 0; _i < 2; ++_i) \
        __builtin_amdgcn_global_load_lds((const unsigned*)((const char*)(gbase) + (voff)[_i]), (LAS unsigned*)(lds + (bufoff) + ldsw + _i * 8192), 16, 0, 0); } while (0)
#define PG8_LDA(dst, b, h) do { _Pragma("unroll") for (int m = 0; m < 4; ++m) _Pragma("unroll") for (int k = 0; k < 2; ++k) dst[m][k] = *(const LAS bf16x8*)(lds + PG8_SA(b, h) + aoff + m * 2048 + k * 1024); } while (0)
#define PG8_LDB(dst, b, h) do { _Pragma("unroll") for (int n = 0; n < 2; ++n) _Pragma("unroll") for (int k = 0; k < 2; ++k) dst[n][k] = *(const LAS bf16x8*)(lds + PG8_SB(b, h) + boff + n * 2048 + k * 1024); } while (0)
#define PG8_MMA(ai, bj, At, Bt_) do { __builtin_amdgcn_s_setprio(1); \
        if constexpr (FP8) { _Pragma("unroll") for (int m = 0; m < 4; ++m) _Pragma("unroll") for (int n = 0; n < 2; ++n) { \
            const i32x8 bw_ = __builtin_shufflevector(__builtin_bit_cast(i32x4, Bt_[n][0]), __builtin_bit_cast(i32x4, Bt_[n][1]), 0, 1, 2, 3, 4, 5, 6, 7); \
            const i32x8 aw_ = __builtin_shufflevector(__builtin_bit_cast(i32x4, At[m][0]), __builtin_bit_cast(i32x4, At[m][1]), 0, 1, 2, 3, 4, 5, 6, 7); \
            asm volatile("v_mfma_scale_f32_16x16x128_f8f6f4 %0, %1, %2, %0, %3, %4 op_sel_hi:[0,0,0]" : "+v"(acc[ai][bj][m][n]) : "v"(bw_), "v"(aw_), "v"(sc_w8), "v"(sc_a8)); } } \
        else { _Pragma("unroll") for (int m = 0; m < 4; ++m) _Pragma("unroll") for (int n = 0; n < 2; ++n) _Pragma("unroll") for (int k = 0; k < 2; ++k) \
            acc[ai][bj][m][n] = __builtin_amdgcn_mfma_f32_16x16x32_bf16(Bt_[n][k], At[m][k], acc[ai][bj][m][n], 0, 0, 0); } \
        __builtin_amdgcn_s_setprio(0); } while (0)
#define PG8_WAIT_V(n) asm volatile("s_waitcnt vmcnt(" #n ")" ::: "memory")
#define PG8_WAIT_L(n) asm volatile("s_waitcnt lgkmcnt(" #n ")" ::: "memory")
#define PG8_BAR __builtin_amdgcn_s_barrier()
#define PG8_SCHED __builtin_amdgcn_sched_barrier(0)
    Unit cur, nxt; int ui = 0;
    if (!S.next(0, cur)) return;
    f32x4 acc[2][2][4][2];
#pragma unroll
    for (int a = 0; a < 2; ++a)
#pragma unroll
        for (int b = 0; b < 2; ++b)
#pragma unroll
            for (int m = 0; m < 4; ++m)
#pragma unroll
                for (int n = 0; n < 2; ++n) acc[a][b][m][n] = (f32x4){0.f, 0.f, 0.f, 0.f};
    bf16x8 At[4][2], B0[2][2], B1[2][2];
    int sc_w8 = 0x7A7A7A7A, sc_a8 = 0x7F7F7F7F;
    asm volatile("" : "+v"(sc_w8), "+v"(sc_a8));
    unsigned cvA0[2], cvA1[2], nvA0[2], nvA1[2];
#pragma unroll
    for (int i = 0; i < 2; ++i) { PG8_RC(i); cvA0[i] = (S.a_row(cur, R_) * (unsigned)K + (unsigned)C_) * 2u; cvA1[i] = (S.a_row(cur, HALF + R_) * (unsigned)K + (unsigned)C_) * 2u; }
    const char* A8 = (const char*)A;
    const char* cB = (const char*)Bt + S.b_off(cur);
    PG8_STAGE(PG8_SB(0, 0), cB, voffB); PG8_STAGE(PG8_SB(0, 1), cB + hstep, voffB); PG8_STAGE(PG8_SA(0, 0), A8, cvA0); PG8_STAGE(PG8_SA(0, 1), A8, cvA1);
    if (wr == 1) PG8_BAR;
    PG8_WAIT_V(2); PG8_BAR;
    PG8_STAGE(PG8_SB(1, 0), cB + kstep, voffB); PG8_STAGE(PG8_SA(1, 0), A8 + kstep, cvA0); PG8_STAGE(PG8_SB(1, 1), cB + hstep + kstep, voffB);
    PG8_WAIT_V(6); PG8_BAR;
    for (;;) {
        const bool has_next = S.next(ui + 1, nxt);
        const char* nB = has_next ? (const char*)Bt + S.b_off(nxt) : cB;
        if (has_next) {
#pragma unroll
            for (int i = 0; i < 2; ++i) { PG8_RC(i); nvA0[i] = (S.a_row(nxt, R_) * (unsigned)K + (unsigned)C_) * 2u; nvA1[i] = (S.a_row(nxt, HALF + R_) * (unsigned)K + (unsigned)C_) * 2u; }
        } else {
#pragma unroll
            for (int i = 0; i < 2; ++i) { nvA0[i] = cvA0[i]; nvA1[i] = cvA1[i]; }
        }
        for (int t = 0; t < nt; t += 2) {
            const bool last = (t == nt - 2);
            const char* a1 = A8 + (size_t)(t + 1) * kstep;
            const char* a2 = last ? A8 : A8 + (size_t)(t + 2) * kstep; const char* b2 = last ? nB : cB + (size_t)(t + 2) * kstep;
            const char* a3 = a2 + kstep; const char* b3 = b2 + kstep;
            unsigned xA0[2], xA1[2];
#pragma unroll
            for (int i = 0; i < 2; ++i) { xA0[i] = last ? nvA0[i] : cvA0[i]; xA1[i] = last ? nvA1[i] : cvA1[i]; }
            PG8_LDB(B0, 0, 0); PG8_LDB(B1, 0, 1); PG8_SCHED; PG8_LDA(At, 0, 0); PG8_STAGE(PG8_SA(1, 1), a1, cvA1);
            PG8_WAIT_V(8); PG8_WAIT_L(0); PG8_BAR; PG8_MMA(0, 0, At, B0); PG8_MMA(0, 1, At, B1); PG8_BAR; PG8_SCHED;
            PG8_LDA(At, 0, 1); PG8_STAGE(PG8_SB(0, 0), b2, voffB); PG8_STAGE(PG8_SB(0, 1), b2 + hstep, voffB); PG8_STAGE(PG8_SA(0, 0), a2, xA0);
            PG8_WAIT_V(8); PG8_WAIT_L(0); PG8_BAR; PG8_MMA(1, 0, At, B0); PG8_MMA(1, 1, At, B1); PG8_BAR; PG8_SCHED;
            PG8_LDB(B0, 1, 0); PG8_LDB(B1, 1, 1); PG8_SCHED; PG8_LDA(At, 1, 0); PG8_STAGE(PG8_SA(0, 1), a2, xA1);
            PG8_WAIT_V(8); PG8_WAIT_L(0); PG8_BAR; PG8_MMA(0, 0, At, B0); PG8_MMA(0, 1, At, B1); PG8_BAR; PG8_SCHED;
            PG8_LDA(At, 1, 1); PG8_STAGE(PG8_SB(1, 0), b3, voffB); PG8_STAGE(PG8_SB(1, 1), b3 + hstep, voffB); PG8_STAGE(PG8_SA(1, 0), a3, xA0);
            PG8_WAIT_V(8); PG8_WAIT_L(0); PG8_BAR; PG8_MMA(1, 0, At, B0); PG8_MMA(1, 1, At, B1); PG8_BAR; PG8_SCHED;
        }
        if (wr == 0) PG8_BAR;
        E(acc, cur, wr, wc, fr, fq);
        if (!has_next) break;
#pragma unroll
        for (int a = 0; a < 2; ++a)
#pragma unroll
            for (int b = 0; b < 2; ++b)
#pragma unroll
                for (int m = 0; m < 4; ++m)
#pragma unroll
                    for (int n = 0; n < 2; ++n) acc[a][b][m][n] = (f32x4){0.f, 0.f, 0.f, 0.f};
        cur = nxt; cB = nB; ++ui;
#pragma unroll
        for (int i = 0; i < 2; ++i) { cvA0[i] = nvA0[i]; cvA1[i] = nvA1[i]; }
        if (wr == 1) PG8_BAR;
    }
    PG8_WAIT_V(0);
    PG8_BAR;
#undef PG8_RC
#undef PG8_SA
#undef PG8_SB
#undef PG8_STAGE
#undef PG8_LDA
#undef PG8_LDB
#undef PG8_MMA
#undef PG8_WAIT_V
#undef PG8_WAIT_L
#undef PG8_BAR
#undef PG8_SCHED
}
}

struct DenseSched {
    pg8::DenseOrder o;
    __device__ __forceinline__ bool next(int i, pg8::Unit& u) const { return o.next(i, u); }
    __device__ __forceinline__ size_t b_off(const pg8::Unit& u) const { return (size_t)u.pn * 256 * DM * 2; }
    __device__ __forceinline__ unsigned a_row(const pg8::Unit& u, int r) const { return (unsigned)(u.pm * 256 + r); }
};
struct MoeSched {
    const LAS int* tab;
    int nNt, G, vc; const unsigned* list; unsigned tokbase; int gather; size_t estride, tstride;
    __device__ __forceinline__ bool next(int i, pg8::Unit& u) const {
        const int L = i * G + vc; const int total = tab[32]; if (L >= total) return false;
        int e = 0;
#pragma unroll 1
        for (int s = 16; s >= 1; s >>= 1) if (tab[e + s] <= L) e += s;
        const int loc = L - tab[e]; u.e = e; u.pm = loc / nNt; u.pn = loc % nNt; u.cnt = tab[64 + e]; u.rbase = tab[128 + e]; return true;
    }
    __device__ __forceinline__ size_t b_off(const pg8::Unit& u) const { return (size_t)u.e * estride + (size_t)u.pn * tstride; }
    __device__ __forceinline__ unsigned a_row(const pg8::Unit& u, int r) const {
        const int pos = u.pm * 256 + r;
        if (gather) { unsigned ent = 0; if (pos < u.cnt) ent = list[(size_t)u.e * LCAP + pos]; return tokbase + (ent >> 2); }
        return (unsigned)(u.rbase + pos);
    }
};

struct EpiProj {
    static constexpr bool PERM = true; bf16_t* O;
    __device__ __forceinline__ void operator()(const f32x4 (&acc)[2][2][4][2], const pg8::Unit& u, int wr, int wc, int fr, int fq) const {
        const int row0 = u.pm * 256 + wr * 64 + fr, col0 = u.pn * 256 + wc * 32 + 8 * fq;
#pragma unroll
        for (int ai = 0; ai < 2; ++ai)
#pragma unroll
            for (int m = 0; m < 4; ++m) { bf16_t* rowp = O + (size_t)(row0 + ai * 128 + m * 16) * INW + col0;
#pragma unroll
                for (int bj = 0; bj < 2; ++bj) { const f32x4 v0 = acc[ai][bj][m][0], v1 = acc[ai][bj][m][1]; u32x4 w;
                    w.x = pg8::cvt_pk_bf16(v0[0], v0[1]); w.y = pg8::cvt_pk_bf16(v0[2], v0[3]); w.z = pg8::cvt_pk_bf16(v1[0], v1[1]); w.w = pg8::cvt_pk_bf16(v1[2], v1[3]);
                    *(u32x4*)(rowp + bj * 128) = w; } }
    }
};
struct EpiResid {
    static constexpr bool PERM = false; const float* X; float* H;
    __device__ __forceinline__ void operator()(const f32x4 (&acc)[2][2][4][2], const pg8::Unit& u, int wr, int wc, int fr, int fq) const {
        const int row0 = u.pm * 256 + wr * 64 + fr, col0 = u.pn * 256 + wc * 32 + 4 * fq;
#pragma unroll
        for (int ai = 0; ai < 2; ++ai)
#pragma unroll
            for (int m = 0; m < 4; ++m) { const size_t off = (size_t)(row0 + ai * 128 + m * 16) * DM + col0;
#pragma unroll
                for (int bj = 0; bj < 2; ++bj)
#pragma unroll
                    for (int n = 0; n < 2; ++n) { const f32x4 xv = *(const f32x4*)(X + off + bj * 128 + n * 16); *(f32x4*)(H + off + bj * 128 + n * 16) = xv + acc[ai][bj][m][n]; } }
    }
};
struct EpiSwiglu {
    static constexpr bool PERM = true; bf16_t* ACT; const float* bgu; int dry;
    __device__ __forceinline__ void operator()(const f32x4 (&acc)[2][2][4][2], const pg8::Unit& u, int wr, int wc, int fr, int fq) const {
        if (dry & 1) return;
        const int f0 = u.pn * 128 + wc * 32 + 8 * fq; const float* bb = bgu + (size_t)u.e * 2 * DFF;
        f32x4 bg[2], bu[2];
#pragma unroll
        for (int n = 0; n < 2; ++n) { bg[n] = *(const f32x4*)(bb + f0 + 4 * n); bu[n] = *(const f32x4*)(bb + DFF + f0 + 4 * n); }
#pragma unroll
        for (int ai = 0; ai < 2; ++ai)
#pragma unroll
            for (int m = 0; m < 4; ++m) { const int pos = u.pm * 256 + ai * 128 + wr * 64 + m * 16 + fr;
                float a[8];
#pragma unroll
                for (int n = 0; n < 2; ++n) { const f32x4 g = acc[ai][0][m][n] + bg[n], up = acc[ai][1][m][n] + bu[n];
#pragma unroll
                    for (int x = 0; x < 4; ++x) { const float gl = fminf(g[x], 7.0f), ul = fminf(fmaxf(up[x], -7.0f), 7.0f); a[4 * n + x] = (ul + 1.0f) * (gl * __builtin_amdgcn_rcpf(1.0f + __builtin_amdgcn_exp2f(-2.4554669595930156f * gl))); } }
#if MOE_FP8_DN
                if (pos < u.cnt && !(dry & 4)) { u32x2 w; w.x = pk4_fp8(a[0], a[1], a[2], a[3]); w.y = pk4_fp8(a[4], a[5], a[6], a[7]); *(u32x2*)((unsigned char*)ACT + (size_t)(u.rbase + pos) * DFF + f0) = w; } }
#else
                if (pos < u.cnt) { u32x4 w; w.x = pg8::cvt_pk_bf16(a[0], a[1]); w.y = pg8::cvt_pk_bf16(a[2], a[3]); w.z = pg8::cvt_pk_bf16(a[4], a[5]); w.w = pg8::cvt_pk_bf16(a[6], a[7]);
                    *(u32x4*)(ACT + (size_t)(u.rbase + pos) * DFF + f0) = w; } }
#endif
    }
};
struct EpiDown {
    static constexpr bool PERM = true; bf16_t* EO; const float* bdn; int dry;
    __device__ __forceinline__ void operator()(const f32x4 (&acc)[2][2][4][2], const pg8::Unit& u, int wr, int wc, int fr, int fq) const {
        if (dry & 1) return;
        const int col0 = u.pn * 256 + wc * 32 + 8 * fq; const float* bb = bdn + (size_t)u.e * DM;
        f32x4 bv[2][2];
#pragma unroll
        for (int bj = 0; bj < 2; ++bj)
#pragma unroll
            for (int n = 0; n < 2; ++n) bv[bj][n] = *(const f32x4*)(bb + col0 + bj * 128 + 4 * n);
#pragma unroll
        for (int ai = 0; ai < 2; ++ai)
#pragma unroll
            for (int m = 0; m < 4; ++m) { const int pos = u.pm * 256 + ai * 128 + wr * 64 + m * 16 + fr;
                if (pos < u.cnt) {
#pragma unroll
                    for (int bj = 0; bj < 2; ++bj) { const f32x4 v0 = acc[ai][bj][m][0] + bv[bj][0], v1 = acc[ai][bj][m][1] + bv[bj][1];
#if EOUT_FP8
                        u32x2 w; w.x = pk4_fp8(v0[0], v0[1], v0[2], v0[3]); w.y = pk4_fp8(v1[0], v1[1], v1[2], v1[3]);
                        *(u32x2*)((unsigned char*)EO + (size_t)(u.rbase + pos) * DM + col0 + bj * 128) = w; }
#else
                        u32x4 w; w.x = pg8::cvt_pk_bf16(v0[0], v0[1]); w.y = pg8::cvt_pk_bf16(v0[2], v0[3]); w.z = pg8::cvt_pk_bf16(v1[0], v1[1]); w.w = pg8::cvt_pk_bf16(v1[2], v1[3]);
                        *(u32x4*)(EO + (size_t)(u.rbase + pos) * DM + col0 + bj * 128) = w; }
#endif
                } }
    }
};

template <int MODE, bool OUT8 = false>
__device__ __forceinline__ void tr_item(const float* W, int K, int N, const float* ksc, bf16_t* WT, LAS float* scr, int item, int lane) {
    const int nblk = N / 32, kb = item / nblk, nb = item % nblk, k0 = 64 * kb, n0 = 32 * nb;
    { const int n4 = (lane & 7) * 4; f32x4 v[8];
#pragma unroll
      for (int i = 0; i < 8; ++i) v[i] = *(const f32x4*)(W + (size_t)(k0 + 8 * i + (lane >> 3)) * N + n0 + n4);
#pragma unroll
      for (int i = 0; i < 8; ++i) { const int kk = 8 * i + (lane >> 3); const float sc = ksc ? ksc[k0 + kk] : 1.0f; LAS float* d = scr + kk * 33 + n4; d[0] = v[i][0] * sc; d[1] = v[i][1] * sc; d[2] = v[i][2] * sc; d[3] = v[i][3] * sc; } }
    LDS_WAIT(); asm volatile("" ::: "memory");
    const int c = lane & 7;
#pragma unroll
    for (int j = 0; j < 4; ++j) { const int n = (lane >> 3) + 8 * j; const LAS float* s = scr + (8 * c) * 33 + n;
        u32x4 o; o.x = pk2(s[0 * 33], s[1 * 33]); o.y = pk2(s[2 * 33], s[3 * 33]); o.z = pk2(s[4 * 33], s[5 * 33]); o.w = pk2(s[6 * 33], s[7 * 33]);
        int row = n0 + n; if (MODE == 1) { const int isup = row >> 10, f = row & 1023; row = (f >> 7) * 256 + isup * 128 + (f & 127); }
        if constexpr (OUT8) { u32x2 o8; o8.x = pk4_fp8(32.f * s[0 * 33], 32.f * s[1 * 33], 32.f * s[2 * 33], 32.f * s[3 * 33]); o8.y = pk4_fp8(32.f * s[4 * 33], 32.f * s[5 * 33], 32.f * s[6 * 33], 32.f * s[7 * 33]);
            *(u32x2*)((unsigned char*)WT + (size_t)row * K + k0 + 8 * c) = o8; }
        else *(u32x4*)(WT + (size_t)row * K + k0 + 8 * c) = o; }
    LDS_WAIT(); asm volatile("" ::: "memory");
}
template <int MODE>
__device__ __forceinline__ void tr_item8(const float* W, int K, int N, const float* ksc, unsigned char* WT, LAS float* scr, int item, int lane) {
    const int nblk = N / 32, kb = item / nblk, nb = item % nblk, k0 = 128 * kb, n0 = 32 * nb;
    { const int n4 = (lane & 7) * 4; f32x4 v[16];
#pragma unroll
      for (int i = 0; i < 16; ++i) v[i] = *(const f32x4*)(W + (size_t)(k0 + 8 * i + (lane >> 3)) * N + n0 + n4);
#pragma unroll
      for (int i = 0; i < 16; ++i) { const int kk = 8 * i + (lane >> 3); const float sc = 32.f * (ksc ? ksc[k0 + kk] : 1.0f); LAS float* d = scr + kk * 33 + n4; d[0] = v[i][0] * sc; d[1] = v[i][1] * sc; d[2] = v[i][2] * sc; d[3] = v[i][3] * sc; } }
    LDS_WAIT(); asm volatile("" ::: "memory");
    const int c = lane & 7;
#pragma unroll
    for (int j = 0; j < 4; ++j) { const int n = (lane >> 3) + 8 * j; const LAS float* s = scr + (16 * c) * 33 + n;
        u32x4 o; o.x = pk4_fp8(s[0 * 33], s[1 * 33], s[2 * 33], s[3 * 33]); o.y = pk4_fp8(s[4 * 33], s[5 * 33], s[6 * 33], s[7 * 33]);
        o.z = pk4_fp8(s[8 * 33], s[9 * 33], s[10 * 33], s[11 * 33]); o.w = pk4_fp8(s[12 * 33], s[13 * 33], s[14 * 33], s[15 * 33]);
        int row = n0 + n; if (MODE == 1) { const int isup = row >> 10, f = row & 1023; row = (f >> 7) * 256 + isup * 128 + (f & 127); }
        *(u32x4*)(WT + (size_t)row * K + k0 + 16 * c) = o; }
    LDS_WAIT(); asm volatile("" ::: "memory");
}
__device__ __forceinline__ void rms_row_to_bf16(const float* xrow, bf16_t* orow, int lane) {
    const f32x4* xr = (const f32x4*)xrow + lane;
    f32x4 v[4]; float s = 0.f;
#pragma unroll
    for (int j = 0; j < 4; ++j) { v[j] = xr[64 * j]; s += (v[j].x * v[j].x + v[j].y * v[j].y) + (v[j].z * v[j].z + v[j].w * v[j].w); }
    const float rs = 1.f / sqrtf(wave_sum(s) * (1.f / DM) + 1e-5f);
    unsigned long long* o8 = (unsigned long long*)orow + lane;
#pragma unroll
    for (int j = 0; j < 4; ++j) o8[64 * j] = (unsigned long long)pk2(v[j].x * rs, v[j].y * rs) | ((unsigned long long)pk2(v[j].z * rs, v[j].w * rs) << 32);
}
__device__ __forceinline__ void phase_prologue(const Args& a, LAS unsigned char* lds, int wave, int lane) {
    LAS float* scr = (LAS float*)(lds + wave * 8704);
    const int gw = blockIdx.x * NWAVES + wave, NGW = gridDim.x * NWAVES;
    bf16_t* Wt_in = (bf16_t*)(a.ws + WS_WIN); bf16_t* Wt_out = (bf16_t*)(a.ws + WS_WOUT);
    constexpr int I_IN = (DM / 64) * (INW / 32), I_OUT = (DM / 64) * (DM / 32);
    for (int it = gw; it < I_IN + I_OUT; it += NGW) {
        if (it < I_IN) tr_item<0>(a.in[I_WIN], DM, INW, a.in[I_GMIX], Wt_in, scr, it, lane);
        else tr_item<0>(a.in[I_WOUT], DM, DM, nullptr, Wt_out, scr, it - I_IN, lane);
    }
    bf16_t* XN = (bf16_t*)(a.ws + WS_XN);
    for (int m = gw; m < MTOK; m += NGW) rms_row_to_bf16(a.in[I_X] + (size_t)m * DM, XN + (size_t)m * DM, lane);
}
__device__ __forceinline__ void expert_weight_items(const Args& a, LAS unsigned char* lds, int wave, int lane, int part, int nparts) {
    bf16_t* Wt_gu = (bf16_t*)(a.ws + WS_WGU); bf16_t* Wt_dn = (bf16_t*)(a.ws + WS_WDN);
#if MOE_FP8_GU && MOE_FP8_DN
    LAS float* scr = (LAS float*)(lds + wave * 16896);
    constexpr int I_GU = (DM / 128) * (2 * DFF / 32), I_DN = (DFF / 128) * (DM / 32);
    constexpr int NITEMS = NE * I_GU + NE * I_DN;
    for (int it = part * NWAVES + wave; it < NITEMS; it += nparts * NWAVES) {
        int r = it;
        if (r < NE * I_GU) { const int e = r / I_GU; tr_item8<1>(a.in[I_WGUP] + (size_t)e * DM * 2 * DFF, DM, 2 * DFF, a.in[I_GFFN], (unsigned char*)Wt_gu + (size_t)e * 2 * DFF * DM, scr, r % I_GU, lane); continue; } r -= NE * I_GU;
        { const int e = r / I_DN; tr_item8<0>(a.in[I_WDN] + (size_t)e * DFF * DM, DFF, DM, nullptr, (unsigned char*)Wt_dn + (size_t)e * DM * DFF, scr, r % I_DN, lane); }
    }
#else
    LAS float* scr = (LAS float*)(lds + wave * 8704);
    constexpr int I_GU = (DM / 64) * (2 * DFF / 32), I_DN = (DFF / 64) * (DM / 32);
    constexpr int NITEMS = NE * I_GU + NE * I_DN;
    for (int it = part * NWAVES + wave; it < NITEMS; it += nparts * NWAVES) {
        int r = it;
        if (r < NE * I_GU) { const int e = r / I_GU; tr_item<1, MOE_FP8_GU != 0>(a.in[I_WGUP] + (size_t)e * DM * 2 * DFF, DM, 2 * DFF, a.in[I_GFFN], (bf16_t*)((unsigned char*)Wt_gu + (size_t)e * 2 * DFF * DM * (MOE_FP8_GU ? 1 : 2)), scr, r % I_GU, lane); continue; } r -= NE * I_GU;
        { const int e = r / I_DN; tr_item<0, MOE_FP8_DN != 0>(a.in[I_WDN] + (size_t)e * DFF * DM, DFF, DM, nullptr, (bf16_t*)((unsigned char*)Wt_dn + (size_t)e * DM * DFF * (MOE_FP8_DN ? 1 : 2)), scr, r % I_DN, lane); }
    }
#endif
}

__device__ __forceinline__ int crow(int r, int hi) { return (r & 3) + 8 * (r >> 2) + 4 * hi; }
__device__ __forceinline__ s16x4 vtr(const LAS unsigned char* p) { typedef short v4i16_t __attribute__((ext_vector_type(4))); return __builtin_bit_cast(s16x4, __builtin_amdgcn_ds_read_tr16_b64_v4i16((LAS v4i16_t*)p)); }
constexpr int ATT_V_BYTES = 49152, ATT_WS_OFF = ATT_V_BYTES, ATT_OST_OFF = ATT_WS_OFF + NWAVES * 256;
__device__ __forceinline__ void attn_task(int T, const bf16_t* proj, bf16_t* opat, float* lse, LAS unsigned char* lds, int tid) {
    const int lane = tid & 63, wave = __builtin_amdgcn_readfirstlane(tid >> 6), r32 = lane & 31, hi = lane >> 5;
    const int b = T / 384, rem = T % 384, g = rem >> 7, h = (rem >> 4) & 7, sub = rem & 15;
    const int dl = (g == 0) ? 1 : (g == 1 ? 4 : 16);
    const int res = sub % dl, qb = sub / dl, u0 = qb * 256;
    const size_t rowb = (size_t)b * SEQ;
    { u32x4 vst[6];
#pragma unroll
      for (int i = 0; i < 6; ++i) { const int c = tid + i * NTHR, ku = c >> 3, ch = c & 7; int uk = u0 - 128 + ku; uk = uk < 0 ? 0 : uk;
          vst[i] = *(const u32x4*)(proj + (rowb + (size_t)uk * dl + res) * INW + 1024 + h * 64 + ch * 8); }
#pragma unroll
      for (int i = 0; i < 6; ++i) { const int c = tid + i * NTHR, ku = c >> 3, ch = c & 7;
          *(LAS u32x4*)(lds + (ch >> 2) * 24576 + (ku >> 4) * 1024 + (ku & 15) * 64 + (ch & 3) * 16) = vst[i]; } }
    int r32o = r32; asm volatile("" : "+v"(r32o));
    const int uq = u0 + 32 * wave + r32o; const size_t rowq = rowb + (size_t)uq * dl + res;
    bf16x8 qf[4];
#pragma unroll
    for (int ds = 0; ds < 4; ++ds) qf[ds] = *(const bf16x8*)(proj + rowq * INW + h * 64 + ds * 16 + hi * 8);
    f32x16 st[5];
#define ATT_KLOAD(dst, kt_) do { int rk = r32o; asm volatile("" : "+v"(rk)); int uk = u0 + 32 * wave - 128 + 32 * (kt_) + rk; if (uk < 0) uk = 0; \
        const bf16_t* kp = proj + (rowb + (size_t)uk * dl + res) * INW + 512 + h * 64 + hi * 8; \
        _Pragma("unroll") for (int ds = 0; ds < 4; ++ds) dst[ds] = *(const bf16x8*)(kp + ds * 16); } while (0)
    { bf16x8 kf[4], kn[4];
      ATT_KLOAD(kf, 0);
#pragma unroll
      for (int kt = 0; kt < 5; ++kt) {
          if (kt < 4) ATT_KLOAD(kn, kt + 1);
          f32x16 s = {};
#pragma unroll
          for (int ds = 0; ds < 4; ++ds) s = __builtin_amdgcn_mfma_f32_32x32x16_bf16(kf[ds], qf[ds], s, 0, 0, 0);
          st[kt] = s;
#pragma unroll
          for (int ds = 0; ds < 4; ++ds) kf[ds] = kn[ds]; } }
#undef ATT_KLOAD
    const float sl2 = exp2f(-(float)(h + 1)) * (float)dl * 1.4426950408889634f;
    const int dq = 128 + r32 - 4 * hi;
    int klo = 128 - u0 - 32 * wave - 4 * hi; if (dq - 128 > klo) klo = dq - 128;
    const float nb = -sl2 * (float)dq;
    float mx = -INFINITY;
#pragma unroll
    for (int kt = 0; kt < 5; ++kt)
#pragma unroll
        for (int r = 0; r < 16; ++r) { const int c = 32 * kt + (r & 3) + 8 * (r >> 2);
            float bias, sc; asm("v_fma_f32 %0, %1, %2, %3" : "=v"(bias) : "v"(sl2), "v"((float)c), "v"(nb));
            asm("v_fma_f32 %0, %1, %2, %3" : "=v"(sc) : "v"(st[kt][r]), "v"(0.18033688011112042f), "v"(bias));
            const bool ok = (c <= dq) && (c >= klo);
            sc = ok ? sc : -INFINITY; st[kt][r] = sc; mx = fmaxf(mx, sc); }
    mx = fmaxf(mx, __shfl_xor(mx, 32));
    float lsum = 0.f;
#pragma unroll
    for (int kt = 0; kt < 5; ++kt)
#pragma unroll
        for (int r = 0; r < 16; ++r) { float df; asm("v_sub_f32 %0, %1, %2" : "=v"(df) : "v"(st[kt][r]), "v"(mx)); const float p = __builtin_amdgcn_exp2f(df); st[kt][r] = p; lsum += p; }
    lsum += __shfl_xor(lsum, 32);
    __syncthreads();
    f32x16 o[2]; o[0] = f32x16{}; o[1] = f32x16{};
    const LAS unsigned char* vb = lds + ((lane >> 4) & 1) * 32 + (lane & 3) * 8 + (4 * hi + ((lane & 15) >> 2)) * 64;
#pragma unroll
    for (int kt = 0; kt < 5; ++kt)
#pragma unroll
        for (int s2 = 0; s2 < 2; ++s2) { const int kg = 2 * wave + 2 * kt + s2;
            u32x4 pw; pw.x = pk2(st[kt][8 * s2 + 0], st[kt][8 * s2 + 1]); pw.y = pk2(st[kt][8 * s2 + 2], st[kt][8 * s2 + 3]); pw.z = pk2(st[kt][8 * s2 + 4], st[kt][8 * s2 + 5]); pw.w = pk2(st[kt][8 * s2 + 6], st[kt][8 * s2 + 7]);
            const bf16x8 pa = __builtin_bit_cast(bf16x8, pw);
#pragma unroll
            for (int d0 = 0; d0 < 2; ++d0) { const LAS unsigned char* p = vb + d0 * 24576 + kg * 1024; const s16x4 lo = vtr(p), hh = vtr(p + 512);
                const bf16x8 vf = (bf16x8){lo[0], lo[1], lo[2], lo[3], hh[0], hh[1], hh[2], hh[3]};
                o[d0] = __builtin_amdgcn_mfma_f32_32x32x16_bf16(pa, vf, o[d0], 0, 0, 0); } asm volatile("" ::: "memory"); }
    LAS float* wsf = (LAS float*)(lds + ATT_WS_OFF) + wave * 64;
    if (hi == 0) wsf[r32] = __builtin_amdgcn_rcpf(lsum);
    LDS_WAIT();
    LAS bf16_t* stg = (LAS bf16_t*)(lds + ATT_OST_OFF) + wave * 2048;
#pragma unroll
    for (int r = 0; r < 16; ++r) { const int orow = crow(r, hi); const float li = wsf[orow];
#pragma unroll
        for (int d0 = 0; d0 < 2; ++d0) stg[orow * 64 + d0 * 32 + r32] = (bf16_t)f2bf(o[d0][r] * li); }
    LDS_WAIT();
    bf16_t* og = opat + (size_t)g * MTOK * 512;
#pragma unroll
    for (int i = 0; i < 4; ++i) { const int row = i * 8 + (lane >> 3), ch = lane & 7; const u32x4 v = *(const LAS u32x4*)(stg + row * 64 + ch * 8);
        const size_t tok = rowb + (size_t)(u0 + 32 * wave + row) * dl + res; *(u32x4*)(og + tok * 512 + h * 64 + ch * 8) = v; }
    if (hi == 0) lse[((size_t)g * MTOK + rowq) * NH + h] = (mx + __log2f(lsum)) * 0.6931471805599453f;
    __syncthreads();
}

constexpr int RT = 32;
__device__ __forceinline__ void rwkv_head(int b, int h, const Args& a, const bf16_t* proj, bf16_t* mix, LAS unsigned char* lds, int tid) {
    const int lane = tid & 63, wave = __builtin_amdgcn_readfirstlane(tid >> 6);
    LAS float* R_ = (LAS float*)lds;
    LAS float* KX = R_ + RT * 64; LAS float* V_ = KX + RT * 64; LAS float* WD = V_ + RT * 64; LAS float* AD = WD + RT * 64;
    LAS float* GD = AD + RT * 64;
    LAS float* DEC = GD + RT * 128; LAS float* KK = DEC + RT * 64; LAS float* BB = KK + RT * 64; LAS float* G_ = BB + RT * 64; LAS float* Y_ = G_ + RT * 64;
    const float* mu = a.in[I_MU];
    const int hc = h * 64 + lane;
    const float w0 = a.in[I_W0][hc], a0 = a.in[I_A0][hc], kkw = a.in[I_KK][hc], kaw = a.in[I_KA][hc], rkw = a.in[I_RK][hc], gnw = a.in[I_GNW][hc], gnb = a.in[I_GNB][hc];
    LAS bf16_t* WL = (LAS bf16_t*)(Y_ + RT * 64);
    __syncthreads();
    for (int i = tid; i < 256 * 64; i += NTHR) { const int l = i >> 6, c = i & 63; const float w = (l < 64) ? a.in[I_WDU][l * 512 + h * 64 + c] : (l < 128 ? a.in[I_WIU][(l - 64) * 512 + h * 64 + c] : a.in[I_WGU][(l - 128) * 512 + h * 64 + c]); WL[i] = (bf16_t)f2bf(w); }
    float Sx[8];
#pragma unroll
    for (int x = 0; x < 8; ++x) Sx[x] = 0.f;
    const int si = 8 * wave + (lane >> 3), jo = lane & 7;
    const size_t rowb = (size_t)b * SEQ;
    for (int blk = 0; blk < SEQ / RT; ++blk) {
        const int t0 = blk * RT;
        for (int it = tid; it < RT * 56; it += NTHR) { const int tt = it / 56, cc = it % 56;
            int col; LAS float* dst; int mode = 0;
            if (cc < 8) { col = 1536 + h * 64 + cc * 8; dst = R_ + tt * 64 + cc * 8; }
            else if (cc < 16) { col = 2048 + h * 64 + (cc - 8) * 8; dst = KX + tt * 64 + (cc - 8) * 8; }
            else if (cc < 24) { col = 2560 + h * 64 + (cc - 16) * 8; dst = V_ + tt * 64 + (cc - 16) * 8; }
            else if (cc < 32) { col = 3072 + (cc - 24) * 8; dst = WD + tt * 64 + (cc - 24) * 8; mode = 1; }
            else if (cc < 40) { col = 3136 + (cc - 32) * 8; dst = AD + tt * 64 + (cc - 32) * 8; }
            else { col = 3200 + (cc - 40) * 8; dst = GD + tt * 128 + (cc - 40) * 8; mode = 2; }
            const bf16_t* p = proj + (rowb + t0 + tt) * INW + col;
            const u32x4 cu = *(const u32x4*)p; u32x4 pv = (u32x4){0u, 0u, 0u, 0u}; if (t0 + tt > 0) pv = *(const u32x4*)(p - INW);
            const f32x4 m0 = *(const f32x4*)(mu + col - 1536), m1 = *(const f32x4*)(mu + col - 1536 + 4);
            float o[8];
#pragma unroll
            for (int q = 0; q < 4; ++q) { const float c0 = bflo(cu[q]), c1 = bfhi(cu[q]), p0 = bflo(pv[q]), p1 = bfhi(pv[q]); const float ma = (q < 2) ? m0[2 * q] : m1[2 * q - 4], mb = (q < 2) ? m0[2 * q + 1] : m1[2 * q - 3];
                o[2 * q] = c0 + (p0 - c0) * ma; o[2 * q + 1] = c1 + (p1 - c1) * mb; }
#pragma unroll
            for (int q = 0; q < 8; ++q) { float v = o[q]; if (mode == 1) v = tanhf(v); else if (mode == 2) v = sigmoidf_(v); dst[q] = v; }
        }
        __syncthreads();
        {
            float wp[4], ap[4], gp[4];
#pragma unroll
            for (int i = 0; i < 4; ++i) { wp[i] = w0; ap[i] = a0; gp[i] = 0.f; }
#pragma unroll 2
            for (int l = 0; l < 64; l += 4) {
                float wd[4], wi[4];
#pragma unroll
                for (int q = 0; q < 4; ++q) { wd[q] = bf2f(WL[(l + q) * 64 + lane]); wi[q] = bf2f(WL[(64 + l + q) * 64 + lane]); }
#pragma unroll
                for (int i = 0; i < 4; ++i) { const f32x4 xw = *(const LAS f32x4*)(WD + (4 * wave + i) * 64 + l), xa = *(const LAS f32x4*)(AD + (4 * wave + i) * 64 + l);
                    wp[i] += xw[0] * wd[0] + xw[1] * wd[1] + xw[2] * wd[2] + xw[3] * wd[3]; ap[i] += xa[0] * wi[0] + xa[1] * wi[1] + xa[2] * wi[2] + xa[3] * wi[3]; } }
#pragma unroll 2
            for (int l = 0; l < 128; l += 4) {
                float wg[4];
#pragma unroll
                for (int q = 0; q < 4; ++q) wg[q] = bf2f(WL[(128 + l + q) * 64 + lane]);
#pragma unroll
                for (int i = 0; i < 4; ++i) { const f32x4 xg = *(const LAS f32x4*)(GD + (4 * wave + i) * 128 + l); gp[i] += xg[0] * wg[0] + xg[1] * wg[1] + xg[2] * wg[2] + xg[3] * wg[3]; } }
#pragma unroll
            for (int i = 0; i < 4; ++i) { const int tt = 4 * wave + i;
                const float z = -wp[i]; const float sp = fmaxf(z, 0.f) + log1pf(__expf(-fabsf(z)));
                const float w = -sp - 0.5f; const float dec = __expf(-__expf(w));
                const float av = sigmoidf_(ap[i]);
                const float kx = KX[tt * 64 + lane]; const float kr = kx * kkw; const float n2 = wave_sum(kr * kr);
                const float kk = kr / fmaxf(sqrtf(n2), 1e-12f);
                DEC[tt * 64 + lane] = dec; KK[tt * 64 + lane] = kk; BB[tt * 64 + lane] = kk * av; KX[tt * 64 + lane] = kx * (1.0f + (av - 1.0f) * kaw); G_[tt * 64 + lane] = gp[i]; }
        }
        __syncthreads();
#pragma unroll 2
        for (int s = 0; s < RT; ++s) {
            const f32x4 k0 = *(const LAS f32x4*)(KK + s * 64 + 8 * jo), k1 = *(const LAS f32x4*)(KK + s * 64 + 8 * jo + 4);
            float sa = Sx[0] * k0[0] + Sx[1] * k0[1] + Sx[2] * k0[2] + Sx[3] * k0[3] + Sx[4] * k1[0] + Sx[5] * k1[1] + Sx[6] * k1[2] + Sx[7] * k1[3];
            sa = sum8(sa);
            const f32x4 d0 = *(const LAS f32x4*)(DEC + s * 64 + 8 * jo), d1 = *(const LAS f32x4*)(DEC + s * 64 + 8 * jo + 4);
            const f32x4 b0 = *(const LAS f32x4*)(BB + s * 64 + 8 * jo), b1 = *(const LAS f32x4*)(BB + s * 64 + 8 * jo + 4);
            const f32x4 x0 = *(const LAS f32x4*)(KX + s * 64 + 8 * jo), x1 = *(const LAS f32x4*)(KX + s * 64 + 8 * jo + 4);
            const f32x4 r0 = *(const LAS f32x4*)(R_ + s * 64 + 8 * jo), r1 = *(const LAS f32x4*)(R_ + s * 64 + 8 * jo + 4);
            const float vi = V_[s * 64 + si];
            float y = 0.f;
#pragma unroll
            for (int x = 0; x < 4; ++x) { Sx[x] = Sx[x] * d0[x] - sa * b0[x] + vi * x0[x]; y += Sx[x] * r0[x]; Sx[4 + x] = Sx[4 + x] * d1[x] - sa * b1[x] + vi * x1[x]; y += Sx[4 + x] * r1[x]; }
            y = sum8(y);
            if (jo == 0) Y_[s * 64 + si] = y;
        }
        __syncthreads();
#pragma unroll
        for (int i = 0; i < 4; ++i) { const int tt = 4 * wave + i;
            const float y = Y_[tt * 64 + lane]; const float mean = wave_sum(y) * (1.f / 64.f); const float dv = y - mean; const float var = wave_sum(dv * dv) * (1.f / 64.f);
            const float yn = dv * (1.0f / sqrtf(var + 64e-5f)) * gnw + gnb;
            const float bs = wave_sum(R_[tt * 64 + lane] * KX[tt * 64 + lane] * rkw);
            const float ov = (yn + bs * V_[tt * 64 + lane]) * G_[tt * 64 + lane];
            mix[(rowb + t0 + tt) * DM + 512 + hc] = (bf16_t)f2bf(ov); }
        __syncthreads();
    }
}

namespace rk {
constexpr int SLOT = 8192, LDF = 68;
constexpr int O_F0 = 16 * SLOT, O_NP = O_F0 + 64 * LDF * 4, O_BP = O_NP + 2048, O_GAM = O_BP + 2048, O_CST = O_GAM + 256, O_PS = O_CST + 5 * 64 * 4, LDP = 36, O_END = O_PS + 64 * LDP * 4;
__device__ __forceinline__ int AD(int r, int c) { return (r << 6) + ((((c >> 3) ^ r) & 7) << 3) + (c & 7); }
__device__ __forceinline__ int AD2(int r, int c) { return (r << 7) + ((((c >> 3) ^ r) & 15) << 3) + (c & 7); }
__device__ __forceinline__ void mm(const LAS bf16_t* Bs, const LAS bf16_t* As, int qb, int pb0, int fr, int kq, f32x4 (&acc)[2]) {
#pragma unroll
    for (int ks = 0; ks < 2; ++ks) { const bf16x8 a = *(const LAS bf16x8*)(As + AD(16 * qb + fr, 32 * ks + 8 * kq));
#pragma unroll
        for (int c = 0; c < 2; ++c) { const bf16x8 b = *(const LAS bf16x8*)(Bs + AD(16 * (pb0 + c) + fr, 32 * ks + 8 * kq)); acc[c] = __builtin_amdgcn_mfma_f32_16x16x32_bf16(a, b, acc[c], 0, 0, 0); } }
}
struct Frag { bf16x8 a[2]; bf16x8 b[2][2]; };
__device__ __forceinline__ void ldf(Frag& f, const LAS bf16_t* Bs, const LAS bf16_t* As, int qb, int pb0, int fr, int kq) {
#pragma unroll
    for (int ks = 0; ks < 2; ++ks) { f.a[ks] = *(const LAS bf16x8*)(As + AD(16 * qb + fr, 32 * ks + 8 * kq));
#pragma unroll
        for (int c = 0; c < 2; ++c) f.b[c][ks] = *(const LAS bf16x8*)(Bs + AD(16 * (pb0 + c) + fr, 32 * ks + 8 * kq)); }
}
__device__ __forceinline__ void mmf(const Frag& f, f32x4 (&acc)[2]) {
#pragma unroll
    for (int ks = 0; ks < 2; ++ks)
#pragma unroll
        for (int c = 0; c < 2; ++c) acc[c] = __builtin_amdgcn_mfma_f32_16x16x32_bf16(f.a[ks], f.b[c][ks], acc[c], 0, 0, 0);
}
__device__ __forceinline__ void mmt(const Frag& f, f32x4 (&acc)[2]) {
#pragma unroll
    for (int ks = 0; ks < 2; ++ks)
#pragma unroll
        for (int c = 0; c < 2; ++c) acc[c] = __builtin_amdgcn_mfma_f32_16x16x32_bf16(f.b[c][ks], f.a[ks], acc[c], 0, 0, 0);
}
#define RK_LOADED() do { __builtin_amdgcn_sched_barrier(0); } while (0)
__device__ __forceinline__ void st4(LAS bf16_t* O, int p, int q0, const f32x4 v) { u32x2 w; w.x = pk2(v[0], v[1]); w.y = pk2(v[2], v[3]); *(LAS u32x2*)(O + AD(p, q0)) = w; }
__device__ __forceinline__ f32x4 ld4(const LAS bf16_t* O, int p, int q0) { const u32x2 w = *(const LAS u32x2*)(O + AD(p, q0)); return (f32x4){bflo(w.x), bfhi(w.x), bflo(w.y), bfhi(w.y)}; }
__device__ __forceinline__ float ex2(float x) { return __builtin_amdgcn_exp2f(x); }
#define RK_ZERO(a) do { a[0] = (f32x4){0.f, 0.f, 0.f, 0.f}; a[1] = (f32x4){0.f, 0.f, 0.f, 0.f}; } while (0)
#define RK_BAR() do { asm volatile("s_waitcnt lgkmcnt(0)" ::: "memory"); __builtin_amdgcn_s_barrier(); asm volatile("" ::: "memory"); } while (0)
}
__device__ __forceinline__ void rwkv_head_chunked(int b, int h, const Args& a, const bf16_t* proj, bf16_t* mix, LAS unsigned char* lds, int tid, const unsigned skip = 0u) {
    using namespace rk;
    const int lane0 = tid & 63, wave = __builtin_amdgcn_readfirstlane(tid >> 6), fr0 = lane0 & 15, kq0 = lane0 >> 4;
    const int qb = wave >> 1, pb0 = 2 * (wave & 1);
    const float L2E = 1.4426950408889634f;
#define SL(i) ((LAS bf16_t*)(lds + (i) * SLOT))
#define SLF(i) ((LAS float*)(lds + (i) * SLOT))
    LAS bf16_t* const SG = SL(0); LAS bf16_t* const SS = SL(1);
    LAS float* const F0 = (LAS float*)(lds + O_F0);
    LAS float* const NP = (LAS float*)(lds + O_NP); LAS float* const BP = (LAS float*)(lds + O_BP); LAS float* const GAM = (LAS float*)(lds + O_GAM);
    const size_t rowb = (size_t)b * SEQ;
    __syncthreads();
    for (int i = tid; i < 64 * 64 / 2; i += NTHR) ((LAS unsigned*)SS)[i] = 0u;
    bf16x8 wfd[2], wfa[2], wfg[4];
    if (skip & 4096u) { wfd[0] = wfd[1] = wfa[0] = wfa[1] = wfg[0] = wfg[1] = wfg[2] = wfg[3] = (bf16x8){0, 0, 0, 0, 0, 0, 0, 0}; } else
    { const int c = h * 64 + 16 * qb + fr0;
#pragma unroll
      for (int ks = 0; ks < 2; ++ks) { u32x4 d, e;
#pragma unroll
          for (int j = 0; j < 4; ++j) { const int l = 32 * ks + 8 * kq0 + 2 * j; d[j] = pk2(a.in[I_WDU][l * 512 + c], a.in[I_WDU][(l + 1) * 512 + c]); e[j] = pk2(a.in[I_WIU][l * 512 + c], a.in[I_WIU][(l + 1) * 512 + c]); }
          wfd[ks] = __builtin_bit_cast(bf16x8, d); wfa[ks] = __builtin_bit_cast(bf16x8, e); }
#pragma unroll
      for (int ks = 0; ks < 4; ++ks) { u32x4 d;
#pragma unroll
          for (int j = 0; j < 4; ++j) { const int l = 32 * ks + 8 * kq0 + 2 * j; d[j] = pk2(a.in[I_WGU][l * 512 + c], a.in[I_WGU][(l + 1) * 512 + c]); }
          wfg[ks] = __builtin_bit_cast(bf16x8, d); } }
    const int j0 = 8 * wave;
    LAS float* const CST = (LAS float*)(lds + O_CST);
    if (tid < 320) { const int which = tid >> 6, c = tid & 63; const float* src = (which == 0) ? a.in[I_W0] : (which == 1) ? a.in[I_A0] : (which == 2) ? a.in[I_KK] : (which == 3) ? a.in[I_KA] : a.in[I_RK]; CST[tid] = src[h * 64 + c]; }
#define c_w0 (CST + 0 + j0)
#define c_a0 (CST + 64 + j0)
#define c_kk (CST + 128 + j0)
#define c_ka (CST + 192 + j0)
#define c_rk (CST + 256 + j0)
    LAS float* const GN = NP + 64; LAS float* const PS = (LAS float*)(lds + O_PS);
    if (tid >= 384) { const int c = tid - 384; GN[c] = (c < 64) ? a.in[I_GNW][h * 64 + c] : a.in[I_GNB][h * 64 + c - 64]; }
    const int gw = (int)((0x74201653u >> (4 * wave)) & 15u);
    const bool ldr = gw < 7; const int cc = ldr ? 8 * gw + (lane0 & 7) : 0, tr = lane0 >> 3;
    int col, dslot, mode = 0;
    if (cc < 8) { col = 1536 + h * 64 + cc * 8; dslot = 2; }
    else if (cc < 16) { col = 2048 + h * 64 + (cc - 8) * 8; dslot = 7; mode = 3; }
    else if (cc < 24) { col = 2560 + h * 64 + (cc - 16) * 8; dslot = 4; }
    else if (cc < 32) { col = 3072 + (cc - 24) * 8; dslot = 3; mode = 1; }
    else if (cc < 40) { col = 3136 + (cc - 32) * 8; dslot = 9; }
    else { col = 3200 + (cc - 40) * 8; dslot = 5; mode = 2; }
    float mu8[8];
    { const f32x4 m0 = *(const f32x4*)(a.in[I_MU] + col - 1536), m1 = *(const f32x4*)(a.in[I_MU] + col - 1536 + 4);
#pragma unroll
      for (int x = 0; x < 4; ++x) { mu8[x] = m0[x]; mu8[4 + x] = m1[x]; } }
    u32x4 raw[9];
    const bf16_t* gsrc = proj + (rowb + 8 * tr) * INW + col;
#define RK_PREFETCH(t0_) do { if (ldr) { const int tf_ = (t0_) + 8 * tr - 1; raw[0] = *(const u32x4*)(gsrc + ((long)(tf_ < 0 ? 0 : tf_) - 8 * tr) * INW); \
        _Pragma("unroll") for (int q = 1; q < 9; ++q) raw[q] = *(const u32x4*)(gsrc + ((long)(t0_) + q - 1) * INW); } } while (0)
    RK_PREFETCH(0);
    RK_BAR();
#pragma unroll 1
    for (int ch = 0; ch < SEQ / 64; ++ch) {
        const int t0 = ch * 64;
        int tl_ = tid; asm volatile("" : "+v"(tl_));
        const int lane = tl_ & 63, fr = lane & 15, kq = lane >> 4;
        if (ldr && !(skip & 1u)) {
            int tro_ = tr; asm volatile("" : "+v"(tro_));
#pragma unroll
            for (int q = 0; q < 8; ++q) { const u32x4 cu = raw[q + 1]; u32x4 pv = raw[q]; if (q == 0 && t0 + tr == 0) pv = (u32x4){0u, 0u, 0u, 0u}; float o[8];
#pragma unroll
                for (int x = 0; x < 4; ++x) { const float c0 = bflo(cu[x]), c1 = bfhi(cu[x]), p0 = bflo(pv[x]), p1 = bfhi(pv[x]); o[2 * x] = c0 + (p0 - c0) * mu8[2 * x]; o[2 * x + 1] = c1 + (p1 - c1) * mu8[2 * x + 1]; }
                if (mode == 1) {
#pragma unroll
                    for (int x = 0; x < 8; ++x) o[x] = 1.0f - 2.0f * __builtin_amdgcn_rcpf(1.0f + ex2(o[x] * (2.0f * L2E)));
                } else if (mode == 2) {
#pragma unroll
                    for (int x = 0; x < 8; ++x) o[x] = __builtin_amdgcn_rcpf(1.0f + ex2(-o[x] * L2E));
                }
                u32x4 w; w.x = pk2(o[0], o[1]); w.y = pk2(o[2], o[3]); w.z = pk2(o[4], o[5]); w.w = pk2(o[6], o[7]);
                { const int row = 8 * tro_ + q; LAS bf16_t* dimg = (LAS bf16_t*)(lds + dslot * SLOT); *(LAS u32x4*)(dimg + ((cc < 40) ? AD(row, 8 * (cc & 7)) : AD2(row, 8 * (cc - 40)))) = w; }
                if (mode == 3) { float n2 = 0.f;
#pragma unroll
                    for (int x = 0; x < 8; ++x) { const float kr_ = o[x] * CST[128 + 8 * (cc & 7) + x]; n2 += kr_ * kr_; }
                    n2 = sum8(n2); if ((lane & 7) == 0) NP[8 * tr + q] = n2; } }
        }
        if (!(skip & 2048u)) RK_BAR();
        if (!(skip & 2u)) { f32x4 aw[2], aa[2], ag[2]; RK_ZERO(aw); RK_ZERO(aa); RK_ZERO(ag);
          bf16x8 bw[2][2], ba[2][2], bg[4][2];
#pragma unroll
          for (int c = 0; c < 2; ++c) { const int t = 16 * (pb0 + c) + fr;
#pragma unroll
              for (int ks = 0; ks < 2; ++ks) { bw[ks][c] = *(const LAS bf16x8*)(SL(3) + AD(t, 32 * ks + 8 * kq)); ba[ks][c] = *(const LAS bf16x8*)(SL(9) + AD(t, 32 * ks + 8 * kq)); }
#pragma unroll
              for (int ks = 0; ks < 4; ++ks) bg[ks][c] = *(const LAS bf16x8*)(SL(5) + AD2(t, 32 * ks + 8 * kq)); }
          RK_LOADED();
#pragma unroll
          for (int c = 0; c < 2; ++c) {
#pragma unroll
              for (int ks = 0; ks < 2; ++ks) { aw[c] = __builtin_amdgcn_mfma_f32_16x16x32_bf16(wfd[ks], bw[ks][c], aw[c], 0, 0, 0); aa[c] = __builtin_amdgcn_mfma_f32_16x16x32_bf16(wfa[ks], ba[ks][c], aa[c], 0, 0, 0); }
#pragma unroll
              for (int ks = 0; ks < 4; ++ks) ag[c] = __builtin_amdgcn_mfma_f32_16x16x32_bf16(wfg[ks], bg[ks][c], ag[c], 0, 0, 0); }
#pragma unroll
          for (int c = 0; c < 2; ++c) { const int t = 16 * (pb0 + c) + fr, q0 = 16 * qb + 4 * kq;
              *(LAS f32x4*)(F0 + t * LDF + q0) = aw[c]; st4(SL(8), t, q0, aa[c]); st4(SG, t, q0, ag[c]); } }
        if (!(skip & 2048u)) RK_BAR();
        u32x4 xv = (u32x4){0u, 0u, 0u, 0u};
        if (!(skip & 4u)) {
          const int rj = AD(lane, j0);
          const u32x4 xk = *(const LAS u32x4*)(SL(7) + rj), xr = *(const LAS u32x4*)(SL(2) + rj), xa = *(const LAS u32x4*)(SL(8) + rj); xv = *(const LAS u32x4*)(SL(4) + rj);
          const f32x4 w0v = *(const LAS f32x4*)(F0 + lane * LDF + j0), w1v = *(const LAS f32x4*)(F0 + lane * LDF + j0 + 4);
          const float rn = __builtin_amdgcn_rsqf(fmaxf(NP[lane], 1e-24f));
          float cw0[8], ca0[8], ckk[8], cka[8], crk[8];
          { const f32x4 t0_ = *(const LAS f32x4*)(CST + j0), t1_ = *(const LAS f32x4*)(CST + j0 + 4), t2_ = *(const LAS f32x4*)(CST + 64 + j0), t3_ = *(const LAS f32x4*)(CST + 64 + j0 + 4);
            const f32x4 t4_ = *(const LAS f32x4*)(CST + 128 + j0), t5_ = *(const LAS f32x4*)(CST + 128 + j0 + 4), t6_ = *(const LAS f32x4*)(CST + 192 + j0), t7_ = *(const LAS f32x4*)(CST + 192 + j0 + 4);
            const f32x4 t8_ = *(const LAS f32x4*)(CST + 256 + j0), t9_ = *(const LAS f32x4*)(CST + 256 + j0 + 4);
#pragma unroll
            for (int x = 0; x < 4; ++x) { cw0[x] = t0_[x]; cw0[4 + x] = t1_[x]; ca0[x] = t2_[x]; ca0[4 + x] = t3_[x]; ckk[x] = t4_[x]; ckk[4 + x] = t5_[x]; cka[x] = t6_[x]; cka[4 + x] = t7_[x]; crk[x] = t8_[x]; crk[4 + x] = t9_[x]; } }
          float kap[8], bet[8], kt[8], rt[8], bg[8], kg[8], bpart = 0.f, lwv[8], cl[8], glv[8];
#pragma unroll
          for (int x = 0; x < 8; ++x) { const float wp = ((x < 4) ? w0v[x] : w1v[x - 4]) + cw0[x]; lwv[x] = (-L2E * 0.6065306597126334f) * __builtin_amdgcn_rcpf(1.0f + ex2(-wp * L2E)); }
#pragma unroll
          for (int x = 0; x < 8; ++x) cl[x] = scan64(lwv[x]);
#pragma unroll
          for (int x = 0; x < 8; ++x) {
              const float kxv = (x & 1) ? bfhi(xk[x >> 1]) : bflo(xk[x >> 1]), r = (x & 1) ? bfhi(xr[x >> 1]) : bflo(xr[x >> 1]);
              const float ap = ((x & 1) ? bfhi(xa[x >> 1]) : bflo(xa[x >> 1])) + ca0[x];
              const float avv = __builtin_amdgcn_rcpf(1.0f + ex2(-ap * L2E));
              const float clL = __builtin_bit_cast(float, __builtin_amdgcn_readlane(__builtin_bit_cast(int, cl[x]), 63));
              const float emc = ex2(-cl[x]), epc = __builtin_amdgcn_rcpf(emc), epx = ex2(lwv[x] * -1.0f + cl[x]), egl = ex2(clL - cl[x]);
              const float kk = kxv * ckk[x] * rn, bq = kk * avv, km = kxv * (1.0f + (avv - 1.0f) * cka[x]);
              kap[x] = epx * kk; bet[x] = bq * emc; kt[x] = km * emc; rt[x] = r * epc; bg[x] = bq * egl; kg[x] = km * egl;
              bpart += r * km * crk[x];
              glv[x] = epc; }
          if (lane == 63) { *(LAS f32x4*)(GAM + j0) = (f32x4){glv[0], glv[1], glv[2], glv[3]}; *(LAS f32x4*)(GAM + j0 + 4) = (f32x4){glv[4], glv[5], glv[6], glv[7]}; }
          BP[wave * 64 + lane] = bpart;
          u32x4 w;
          w.x = pk2(kap[0], kap[1]); w.y = pk2(kap[2], kap[3]); w.z = pk2(kap[4], kap[5]); w.w = pk2(kap[6], kap[7]); *(LAS u32x4*)(SL(9) + rj) = w;
          w.x = pk2(bet[0], bet[1]); w.y = pk2(bet[2], bet[3]); w.z = pk2(bet[4], bet[5]); w.w = pk2(bet[6], bet[7]); *(LAS u32x4*)(SL(10) + rj) = w;
          w.x = pk2(kt[0], kt[1]); w.y = pk2(kt[2], kt[3]); w.z = pk2(kt[4], kt[5]); w.w = pk2(kt[6], kt[7]); *(LAS u32x4*)(SL(11) + rj) = w;
          w.x = pk2(rt[0], rt[1]); w.y = pk2(rt[2], rt[3]); w.z = pk2(rt[4], rt[5]); w.w = pk2(rt[6], rt[7]); *(LAS u32x4*)(SL(12) + rj) = w;
#pragma unroll
          for (int x = 0; x < 8; ++x) { const int tj = AD(j0 + x, lane); SL(5)[tj] = (bf16_t)f2bf(kap[x]); SL(6)[tj] = (bf16_t)f2bf(bg[x]); SL(3)[tj] = (bf16_t)f2bf(kg[x]);
              SL(13)[tj] = (bf16_t)((x & 1) ? (xv[x >> 1] >> 16) : (xv[x >> 1] & 0xffffu)); } }
        if (!(skip & 2048u)) RK_BAR();
        if (ch + 1 < SEQ / 64 && !(skip & 1024u)) RK_PREFETCH(t0 + 64);
        const int q0 = 16 * qb + 4 * kq;
        if (!(skip & 32u)) { f32x4 a1[2], a2[2], a3[2], a4[2], a5[2]; RK_ZERO(a1); RK_ZERO(a2); RK_ZERO(a3); RK_ZERO(a4); RK_ZERO(a5);
          { Frag f1, f3; ldf(f1, SL(9), SL(10), qb, pb0, fr, kq); ldf(f3, SL(11), SL(9), qb, pb0, fr, kq); RK_LOADED();
            mmf(f1, a1);
            mmt(f1, a2);
            mmf(f3, a3); }
          { Frag f4, f5; ldf(f4, SL(12), SL(10), qb, pb0, fr, kq); ldf(f5, SL(12), SL(11), qb, pb0, fr, kq); RK_LOADED();
            mmf(f4, a4);
            mmf(f5, a5); }
#pragma unroll
          for (int c = 0; c < 2; ++c) { const int p = 16 * (pb0 + c) + fr;
#pragma unroll
              for (int x = 0; x < 4; ++x) { const int q = q0 + x; a1[c][x] = (q < p) ? a1[c][x] : 0.f; a2[c][x] = (16 * qb + fr < 16 * (pb0 + c) + 4 * kq + x) ? a2[c][x] : 0.f; a3[c][x] = (p < q) ? a3[c][x] : 0.f; a4[c][x] = (q <= p) ? a4[c][x] : 0.f; a5[c][x] = (q <= p) ? a5[c][x] : 0.f; }
              st4(SL(2), p, q0, a1[c]); st4(SL(4), 16 * qb + fr, 16 * (pb0 + c) + 4 * kq, a2[c]); st4(SL(7), p, q0, a3[c]); st4(SL(8), p, q0, a4[c]); st4(SL(14), p, q0, a5[c]); } }
        if (!(skip & 2048u)) RK_BAR();
        if (!(skip & 64u)) { f32x4 a1[2], a2[2]; RK_ZERO(a1); RK_ZERO(a2);
          { Frag f1; ldf(f1, SL(2), SL(4), qb, pb0, fr, kq); RK_LOADED();
            mmf(f1, a1);
            mmt(f1, a2); }
#pragma unroll
          for (int c = 0; c < 2; ++c) { const int p = 16 * (pb0 + c) + fr; st4(SL(9), p, q0, a1[c]); st4(SL(10), 16 * qb + fr, 16 * (pb0 + c) + 4 * kq, a2[c]); } }
        if (!(skip & 2048u)) RK_BAR();
        if (!(skip & 64u)) { f32x4 a1[2], a2[2], a3[2]; RK_ZERO(a1); RK_ZERO(a2); RK_ZERO(a3);
          f32x4 x1[2];
          { Frag f1, f3; ldf(f1, SL(9), SL(10), qb, pb0, fr, kq); ldf(f3, SL(2), SL(10), qb, pb0, fr, kq);
            f32x4 pv[2], qv[2];
#pragma unroll
            for (int c = 0; c < 2; ++c) { const int p = 16 * (pb0 + c) + fr; pv[c] = ld4(SL(2), p, q0); qv[c] = ld4(SL(9), p, q0); }
            RK_LOADED();
            mmf(f1, a1); mmt(f1, a2); mmf(f3, a3);
#pragma unroll
            for (int c = 0; c < 2; ++c) { const int p = 16 * (pb0 + c) + fr;
#pragma unroll
                for (int x = 0; x < 4; ++x) x1[c][x] = ((q0 + x == p) ? 1.0f : 0.0f) - pv[c][x] + qv[c][x] - a3[c][x]; } }
#pragma unroll
          for (int c = 0; c < 2; ++c) { const int p = 16 * (pb0 + c) + fr; st4(SL(11), p, q0, a1[c]); st4(SL(4), 16 * qb + fr, 16 * (pb0 + c) + 4 * kq, a2[c]); st4(SL(15), p, q0, x1[c]); } }
        if (!(skip & 2048u)) RK_BAR();
        if (!(skip & 64u)) { f32x4 a1[2], a2[2], a3[2]; RK_ZERO(a1); RK_ZERO(a2); RK_ZERO(a3);
          { Frag f1, f3; ldf(f1, SL(11), SL(4), qb, pb0, fr, kq); ldf(f3, SL(15), SL(4), qb, pb0, fr, kq);
#pragma unroll
            for (int c = 0; c < 2; ++c) a3[c] = ld4(SL(15), 16 * (pb0 + c) + fr, q0);
            RK_LOADED(); mmf(f1, a1); mmt(f1, a2); mmf(f3, a3); }
#pragma unroll
          for (int c = 0; c < 2; ++c) { const int p = 16 * (pb0 + c) + fr; st4(SL(2), p, q0, a1[c]); st4(SL(9), 16 * qb + fr, 16 * (pb0 + c) + 4 * kq, a2[c]); st4(SL(10), p, q0, a3[c]); } }
        if (!(skip & 2048u)) RK_BAR();
        if (!(skip & 64u)) { f32x4 a1[2], a2[2], a3[2]; RK_ZERO(a1); RK_ZERO(a2); RK_ZERO(a3);
          { Frag f1, f3; ldf(f1, SL(2), SL(9), qb, pb0, fr, kq); ldf(f3, SL(10), SL(9), qb, pb0, fr, kq);
#pragma unroll
            for (int c = 0; c < 2; ++c) a3[c] = ld4(SL(10), 16 * (pb0 + c) + fr, q0);
            RK_LOADED(); mmf(f1, a1); mmt(f1, a2); mmf(f3, a3); }
#pragma unroll
          for (int c = 0; c < 2; ++c) { const int p = 16 * (pb0 + c) + fr; st4(SL(11), p, q0, a1[c]); st4(SL(4), 16 * qb + fr, 16 * (pb0 + c) + 4 * kq, a2[c]); st4(SL(15), p, q0, a3[c]); } }
        if (!(skip & 2048u)) RK_BAR();
        if (!(skip & 64u)) { f32x4 a2[2], a3[2]; RK_ZERO(a2); RK_ZERO(a3);
          { Frag f1, f3; ldf(f1, SL(11), SL(4), qb, pb0, fr, kq); ldf(f3, SL(15), SL(4), qb, pb0, fr, kq);
#pragma unroll
            for (int c = 0; c < 2; ++c) a3[c] = ld4(SL(15), 16 * (pb0 + c) + fr, q0);
            RK_LOADED(); mmt(f1, a2); mmf(f3, a3); }
#pragma unroll
          for (int c = 0; c < 2; ++c) { const int p = 16 * (pb0 + c) + fr; st4(SL(9), 16 * qb + fr, 16 * (pb0 + c) + 4 * kq, a2[c]); st4(SL(10), p, q0, a3[c]); } }
        if (!(skip & 2048u)) RK_BAR();
        if (!(skip & 64u)) { f32x4 a3[2]; RK_ZERO(a3);
          { Frag f3; ldf(f3, SL(10), SL(9), qb, pb0, fr, kq);
#pragma unroll
            for (int c = 0; c < 2; ++c) a3[c] = ld4(SL(10), 16 * (pb0 + c) + fr, q0);
            RK_LOADED(); mmf(f3, a3); }
#pragma unroll
          for (int c = 0; c < 2; ++c) st4(SL(15), 16 * (pb0 + c) + fr, q0, a3[c]); }
        if (!(skip & 2048u)) RK_BAR();
        if (!(skip & 128u)) { f32x4 a1[2], a2[2]; RK_ZERO(a1); RK_ZERO(a2);
          { Frag f1, f2; ldf(f1, SL(5), SL(15), qb, pb0, fr, kq); ldf(f2, SL(7), SL(15), qb, pb0, fr, kq); RK_LOADED(); mmf(f1, a1); mmf(f2, a2); }
#pragma unroll
          for (int c = 0; c < 2; ++c) { const int p = 16 * (pb0 + c) + fr; st4(SL(2), p, q0, a1[c]); st4(SL(4), p, q0, a2[c]); } }
        if (!(skip & 2048u)) RK_BAR();
        if (!(skip & 128u)) { f32x4 a1[2], a2[2], a3[2], a4[2]; RK_ZERO(a1); RK_ZERO(a2); RK_ZERO(a3); RK_ZERO(a4);
          f32x4 i1[2], i2[2], i4[2];
          { Frag f1, f2, f3, f4; ldf(f1, SL(8), SL(2), qb, pb0, fr, kq); ldf(f2, SL(8), SL(4), qb, pb0, fr, kq); ldf(f3, SL(6), SL(2), qb, pb0, fr, kq); ldf(f4, SL(6), SL(4), qb, pb0, fr, kq);
#pragma unroll
            for (int c = 0; c < 2; ++c) { const int p = 16 * (pb0 + c) + fr; i1[c] = ld4(SL(12), p, q0); i2[c] = ld4(SL(14), p, q0); i4[c] = ld4(SL(3), p, q0); }
            RK_LOADED(); mmf(f1, a1); mmf(f2, a2); mmf(f3, a3); mmf(f4, a4); }
#pragma unroll
          for (int c = 0; c < 2; ++c) { const int p = 16 * (pb0 + c) + fr;
              a1[c] = i1[c] - a1[c]; a2[c] = i2[c] - a2[c]; a4[c] = i4[c] - a4[c];
#pragma unroll
              for (int x = 0; x < 4; ++x) a3[c][x] = ((q0 + x == p) ? GAM[p] : 0.0f) - a3[c][x];
              st4(SL(12), p, q0, a1[c]); st4(SL(14), p, q0, a2[c]); st4(SL(9), p, q0, a3[c]); st4(SL(3), p, q0, a4[c]); } }
        if (!(skip & 2048u)) RK_BAR();
        f32x4 sn[2]; RK_ZERO(sn);
        if (!(skip & 256u)) { f32x4 ay[2]; RK_ZERO(ay);
          { Frag f1, f2, f3, f4; ldf(f1, SL(12), SS, qb, pb0, fr, kq); ldf(f2, SL(14), SL(13), qb, pb0, fr, kq); ldf(f3, SS, SL(9), qb, pb0, fr, kq); ldf(f4, SL(13), SL(3), qb, pb0, fr, kq);
            RK_LOADED(); mmf(f1, ay); mmf(f2, ay); mmf(f3, sn); mmf(f4, sn); }
#pragma unroll
          for (int c = 0; c < 2; ++c) { const int t = 16 * (pb0 + c) + fr; *(LAS f32x4*)(F0 + t * LDF + q0) = ay[c];
              f32x2 pm; pm.x = (ay[c][0] + ay[c][1]) + (ay[c][2] + ay[c][3]); pm.y = (ay[c][0] * ay[c][0] + ay[c][1] * ay[c][1]) + (ay[c][2] * ay[c][2] + ay[c][3] * ay[c][3]);
              *(LAS f32x2*)(PS + t * LDP + 2 * (4 * qb + kq)) = pm; } }
        if (!(skip & 2048u)) RK_BAR();
#pragma unroll
        for (int c = 0; c < 2; ++c) st4(SS, 16 * (pb0 + c) + fr, q0, sn[c]);
        if (!(skip & 512u)) {
            const f32x4 y0 = *(const LAS f32x4*)(F0 + lane * LDF + j0), y1 = *(const LAS f32x4*)(F0 + lane * LDF + j0 + 4);
            float s1 = 0.f, s2 = 0.f;
#pragma unroll
            for (int k4 = 0; k4 < 8; ++k4) { const f32x4 p = *(const LAS f32x4*)(PS + lane * LDP + 4 * k4); s1 += p[0] + p[2]; s2 += p[1] + p[3]; }
            float bs = 0.f;
#pragma unroll
            for (int w = 0; w < 8; ++w) bs += BP[w * 64 + lane];
            const u32x4 gq = *(const LAS u32x4*)(SG + AD(lane, j0));
            const f32x4 gw0 = *(const LAS f32x4*)(GN + j0), gw1 = *(const LAS f32x4*)(GN + j0 + 4), gb0 = *(const LAS f32x4*)(GN + 64 + j0), gb1 = *(const LAS f32x4*)(GN + 64 + j0 + 4);
            const float mean = s1 * (1.f / 64.f), var = fmaxf(s2 * (1.f / 64.f) - mean * mean, 0.f), rstd = __builtin_amdgcn_rsqf(var + 64e-5f);
            float o[8];
#pragma unroll
            for (int x = 0; x < 8; ++x) { const float y = (x < 4) ? y0[x] : y1[x - 4], gnw = (x < 4) ? gw0[x] : gw1[x - 4], gnb = (x < 4) ? gb0[x] : gb1[x - 4];
                const float vv = (x & 1) ? bfhi(xv[x >> 1]) : bflo(xv[x >> 1]), gg = (x & 1) ? bfhi(gq[x >> 1]) : bflo(gq[x >> 1]);
                o[x] = ((y - mean) * rstd * gnw + gnb + bs * vv) * gg; }
            u32x4 w; w.x = pk2(o[0], o[1]); w.y = pk2(o[2], o[3]); w.z = pk2(o[4], o[5]); w.w = pk2(o[6], o[7]);
            if (!(skip & 0x80000000u)) *(u32x4*)(mix + (rowb + t0 + lane) * DM + 512 + h * 64 + j0) = w; }
    }
#undef RK_PREFETCH
#undef SL
#undef SLF
#undef c_w0
#undef c_a0
#undef c_kk
#undef c_ka
#undef c_rk
}

__device__ __forceinline__ void phase_merge(const bf16_t* opat, const float* lse, bf16_t* mix, int tid, int part, int nparts) {
    const size_t total = (size_t)MTOK * 64, stride = (size_t)nparts * NTHR;
    for (size_t idx = (size_t)part * NTHR + tid; idx < total; idx += stride) {
        const size_t tok = idx >> 6; const int hd = (int)(idx & 63), h = hd >> 3, ch = hd & 7;
        const float l0 = lse[(0 * (size_t)MTOK + tok) * NH + h], l1 = lse[(1 * (size_t)MTOK + tok) * NH + h], l2 = lse[(2 * (size_t)MTOK + tok) * NH + h];
        const float m = fmaxf(l0, fmaxf(l1, l2)); float w0 = __expf(l0 - m), w1 = __expf(l1 - m), w2 = __expf(l2 - m); const float inv = 1.0f / (w0 + w1 + w2); w0 *= inv; w1 *= inv; w2 *= inv;
        const size_t off = tok * 512 + h * 64 + ch * 8;
        const u32x4 a0 = *(const u32x4*)(opat + off), a1 = *(const u32x4*)(opat + (size_t)MTOK * 512 + off), a2 = *(const u32x4*)(opat + 2 * (size_t)MTOK * 512 + off);
        u32x4 o;
#pragma unroll
        for (int q = 0; q < 4; ++q) o[q] = pk2(w0 * bflo(a0[q]) + w1 * bflo(a1[q]) + w2 * bflo(a2[q]), w0 * bfhi(a0[q]) + w1 * bfhi(a1[q]) + w2 * bfhi(a2[q]));
        *(u32x4*)(mix + tok * DM + h * 64 + ch * 8) = o;
    }
}

constexpr int RT_WROW = 520;
constexpr int RT_WTL = 32 * RT_WROW * 2, RT_P = 2 * RT_WTL, RT_RS = RT_P + 128 * 33 * 4;
__device__ __forceinline__ void phase_route(int slab, const Args& a, LAS unsigned char* lds, int tid, const int dry = 0) {
    const int lane = tid & 63, wave = __builtin_amdgcn_readfirstlane(tid >> 6), fr = lane & 15, kq = lane >> 4;
    LAS bf16_t* WTH = (LAS bf16_t*)lds; LAS bf16_t* WTL = (LAS bf16_t*)(lds + RT_WTL);
    LAS float* P = (LAS float*)(lds + RT_P); LAS float* RS = (LAS float*)(lds + RT_RS);
    LAS int* lcnt = (LAS int*)(lds + MISC_OFF); LAS int* gbase = lcnt + 32;
    const float* h = a.out; bf16_t* XN = (bf16_t*)(a.ws + WS_XN2);
    unsigned* cnt = (unsigned*)(a.ws + WS_CTL) + CW_CNT + slab * 32 * 16;
    unsigned* list = (unsigned*)(a.ws + WS_LIST) + (size_t)slab * NE * LCAP; unsigned* tokinfo = (unsigned*)(a.ws + WS_GLIST) + (size_t)slab * SLABT * 8;
    const float* wr = a.in[I_WR]; const float* gf = a.in[I_GFFN]; const float* br = a.in[I_BR];
    for (int batch = blockIdx.x; batch < SLABT / 128; batch += gridDim.x) {
        const int row0 = slab * SLABT + batch * 128;
        const float* hrow = h + (size_t)(row0 + wave * 16 + fr) * DM + 8 * kq;
        f32x4 acc0 = {0.f, 0.f, 0.f, 0.f}, acc1 = {0.f, 0.f, 0.f, 0.f}; float ss = 0.f;
        if (tid < 32) lcnt[tid] = 0;
#pragma unroll 1
        for (int kh = 0; kh < 2; ++kh) {
            __syncthreads();
            for (int i = tid; i < 512 * 32; i += NTHR) { const int kk = i >> 5, e = i & 31; const float v = wr[(kh * 512 + kk) * 32 + e] * gf[kh * 512 + kk];
                const unsigned hb = f2bf(v); const unsigned lb = f2bf(v - bf2f((unsigned short)hb)); WTH[e * RT_WROW + kk] = (bf16_t)hb; WTL[e * RT_WROW + kk] = (bf16_t)lb; }
            __syncthreads();
#pragma unroll 8
            for (int ks = 0; ks < 16; ++ks) {
                const f32x4 x0 = *(const f32x4*)(hrow + kh * 512 + 32 * ks), x1 = *(const f32x4*)(hrow + kh * 512 + 32 * ks + 4);
                ss += (x0[0] * x0[0] + x0[1] * x0[1]) + (x0[2] * x0[2] + x0[3] * x0[3]) + (x1[0] * x1[0] + x1[1] * x1[1]) + (x1[2] * x1[2] + x1[3] * x1[3]);
                float xv[8] = {x0[0], x0[1], x0[2], x0[3], x1[0], x1[1], x1[2], x1[3]}; unsigned hb[8], lb[8];
#pragma unroll
                for (int q = 0; q < 8; ++q) { hb[q] = f2bf(xv[q]); lb[q] = f2bf(xv[q] - bf2f((unsigned short)hb[q])); }
                u32x4 ah, al;
#pragma unroll
                for (int q = 0; q < 4; ++q) { ah[q] = hb[2 * q] | (hb[2 * q + 1] << 16); al[q] = lb[2 * q] | (lb[2 * q + 1] << 16); }
                const bf16x8 Ah = __builtin_bit_cast(bf16x8, ah), Al = __builtin_bit_cast(bf16x8, al);
                const bf16x8 Bh0 = *(const LAS bf16x8*)(WTH + fr * RT_WROW + 32 * ks + 8 * kq), Bl0 = *(const LAS bf16x8*)(WTL + fr * RT_WROW + 32 * ks + 8 * kq);
                const bf16x8 Bh1 = *(const LAS bf16x8*)(WTH + (16 + fr) * RT_WROW + 32 * ks + 8 * kq), Bl1 = *(const LAS bf16x8*)(WTL + (16 + fr) * RT_WROW + 32 * ks + 8 * kq);
                acc0 = __builtin_amdgcn_mfma_f32_16x16x32_bf16(Ah, Bh0, acc0, 0, 0, 0); acc0 = __builtin_amdgcn_mfma_f32_16x16x32_bf16(Ah, Bl0, acc0, 0, 0, 0); acc0 = __builtin_amdgcn_mfma_f32_16x16x32_bf16(Al, Bh0, acc0, 0, 0, 0);
                acc1 = __builtin_amdgcn_mfma_f32_16x16x32_bf16(Ah, Bh1, acc1, 0, 0, 0); acc1 = __builtin_amdgcn_mfma_f32_16x16x32_bf16(Ah, Bl1, acc1, 0, 0, 0); acc1 = __builtin_amdgcn_mfma_f32_16x16x32_bf16(Al, Bh1, acc1, 0, 0, 0);
            }
        }
        ss += __shfl_xor(ss, 16); ss += __shfl_xor(ss, 32);
        if (kq == 0) RS[wave * 16 + fr] = 1.0f / sqrtf(ss * (1.f / DM) + 1e-5f);
#pragma unroll
        for (int r = 0; r < 4; ++r) { P[(wave * 16 + kq * 4 + r) * 33 + fr] = acc0[r]; P[(wave * 16 + kq * 4 + r) * 33 + 16 + fr] = acc1[r]; }
        __syncthreads();
        int te[4] = {0, 0, 0, 0}; float tg[4] = {0.f, 0.f, 0.f, 0.f}; int lp[4] = {0, 0, 0, 0};
        if (tid < 128) { const float rs = RS[tid]; float tv[4] = {-INFINITY, -INFINITY, -INFINITY, -INFINITY};
#pragma unroll 1
            for (int e = 0; e < 32; ++e) { const float v = P[tid * 33 + e] * rs + br[e];
                if (v > tv[3]) { if (v > tv[0]) { tv[3] = tv[2]; te[3] = te[2]; tv[2] = tv[1]; te[2] = te[1]; tv[1] = tv[0]; te[1] = te[0]; tv[0] = v; te[0] = e; }
                    else if (v > tv[1]) { tv[3] = tv[2]; te[3] = te[2]; tv[2] = tv[1]; te[2] = te[1]; tv[1] = v; te[1] = e; }
                    else if (v > tv[2]) { tv[3] = tv[2]; te[3] = te[2]; tv[2] = v; te[2] = e; }
                    else { tv[3] = v; te[3] = e; } } }
            const float e1 = __expf(tv[1] - tv[0]), e2 = __expf(tv[2] - tv[0]), e3 = __expf(tv[3] - tv[0]); const float inv = 1.0f / (1.0f + e1 + e2 + e3);
            tg[0] = inv; tg[1] = e1 * inv; tg[2] = e2 * inv; tg[3] = e3 * inv;
#pragma unroll
            for (int k = 0; k < 4; ++k) lp[k] = atomicAdd((int*)(lcnt + te[k]), 1); }
        __syncthreads();
        if (tid < 32) gbase[tid] = dry ? 0 : (int)atomicAdd(cnt + tid * 16, (unsigned)lcnt[tid]);
        __syncthreads();
        if (tid < 128 && !dry) {
#pragma unroll
            for (int k = 0; k < 4; ++k) { const int pos = gbase[te[k]] + lp[k]; list[(size_t)te[k] * LCAP + pos] = (unsigned)((batch * 128 + tid) * 4 + k); lp[k] = pos; }
            u32x4* ti = (u32x4*)(tokinfo + (size_t)(batch * 128 + tid) * 8);
            ti[0] = (u32x4){((unsigned)te[0] << 24) | (unsigned)lp[0], ((unsigned)te[1] << 24) | (unsigned)lp[1], ((unsigned)te[2] << 24) | (unsigned)lp[2], ((unsigned)te[3] << 24) | (unsigned)lp[3]};
            ti[1] = (u32x4){__builtin_bit_cast(unsigned, tg[0]), __builtin_bit_cast(unsigned, tg[1]), __builtin_bit_cast(unsigned, tg[2]), __builtin_bit_cast(unsigned, tg[3])}; }
#pragma unroll 4
        for (int r = 0; r < 16; ++r) { const int rw = wave * 16 + r; const float rs = RS[rw]; const f32x4* xr = (const f32x4*)(h + (size_t)(row0 + rw) * DM) + lane;
#if MOE_FP8_GU
            unsigned* o4 = (unsigned*)((unsigned char*)XN + (size_t)(row0 + rw) * DM) + lane;
#pragma unroll
            for (int j = 0; j < 4; ++j) { const f32x4 v = xr[64 * j]; o4[64 * j] = pk4_fp8(v.x * rs, v.y * rs, v.z * rs, v.w * rs); } }
#else
            unsigned long long* o8 = (unsigned long long*)(XN + (size_t)(row0 + rw) * DM) + lane;
#pragma unroll
            for (int j = 0; j < 4; ++j) { const f32x4 v = xr[64 * j]; o8[64 * j] = (unsigned long long)pk2(v.x * rs, v.y * rs) | ((unsigned long long)pk2(v.z * rs, v.w * rs) << 32); } }
#endif
        __syncthreads();
    }
}
__device__ __forceinline__ void moe_tables(int slab, const Args& a, LAS unsigned char* lds, int nNt, int tid) {
    LAS int* tab = (LAS int*)(lds + MISC_OFF);
    const unsigned* cnt = (const unsigned*)(a.ws + WS_CTL) + CW_CNT + slab * 32 * 16;
    if (tid == 0) { int tp = 0, rb = 0;
        for (int e = 0; e < NE; ++e) { const int c = (int)__hip_atomic_load(cnt + e * 16, __ATOMIC_RELAXED, __HIP_MEMORY_SCOPE_AGENT); const int mt = (c + 255) >> 8; tab[e] = tp; tab[64 + e] = c; tab[128 + e] = rb; tp += mt * nNt; rb += mt * 256; }
        tab[32] = tp; }
    __syncthreads();
}
__device__ __forceinline__ void phase_final(int slab, const Args& a, LAS unsigned char* lds, int tid, const int dry = 0) {
    const int lane = tid & 63, wave = __builtin_amdgcn_readfirstlane(tid >> 6);
    moe_tables(slab, a, lds, 4, tid);
    const LAS int* tab = (const LAS int*)(lds + MISC_OFF);
    const unsigned char* EO = (const unsigned char*)(a.ws + WS_EOUT); const float* gfin = a.in[I_GFIN];
    constexpr int EB = EOUT_FP8 ? 1 : 2;
    const unsigned* tokinfo = (const unsigned*)(a.ws + WS_GLIST) + (size_t)slab * SLABT * 8;
    const int gw = blockIdx.x * NWAVES + wave, NGW = gridDim.x * NWAVES;
    f32x4 gf[4];
#pragma unroll
    for (int j = 0; j < 4; ++j) gf[j] = *((const f32x4*)gfin + lane + 64 * j);
    u32x4 inf[2], gin[2];
#pragma unroll
    for (int r = 0; r < 2; ++r) { const int rl = gw + r * NGW; const int rc = rl < SLABT ? rl : 0; inf[r] = *(const u32x4*)(tokinfo + (size_t)rc * 8); gin[r] = *(const u32x4*)(tokinfo + (size_t)rc * 8 + 4); }
    for (int rl0 = gw; rl0 < SLABT; rl0 += 2 * NGW) {
        const unsigned char* er[2][4]; float gk[2][4];
#pragma unroll
        for (int r = 0; r < 2; ++r)
#pragma unroll
            for (int k = 0; k < 4; ++k) { const unsigned w = __builtin_amdgcn_readfirstlane(inf[r][k]); er[r][k] = EO + (size_t)(tab[128 + (w >> 24)] + (int)(w & 0xffffffu)) * DM * EB; gk[r][k] = __builtin_bit_cast(float, __builtin_amdgcn_readfirstlane(gin[r][k])); }
#if EOUT_FP8
        f32x4 v[2][4]; unsigned ew[2][4][4];
#else
        f32x4 v[2][4]; u32x2 ew[2][4][4];
#endif
#pragma unroll
        for (int r = 0; r < 2; ++r) { const int rl = rl0 + r * NGW; const int rc = rl < SLABT ? rl : rl0; const float* hr = a.out + (size_t)(slab * SLABT + rc) * DM;
#pragma unroll
            for (int j = 0; j < 4; ++j) { v[r][j] = *((const f32x4*)hr + lane + 64 * j);
#pragma unroll
#if EOUT_FP8
                for (int k = 0; k < 4; ++k) ew[r][j][k] = *((const unsigned*)er[r][k] + lane + 64 * j); } }
#else
                for (int k = 0; k < 4; ++k) ew[r][j][k] = *((const u32x2*)er[r][k] + lane + 64 * j); } }
#endif
#pragma unroll
        for (int r = 0; r < 2; ++r) { const int rn = rl0 + (2 + r) * NGW; const int rc = rn < SLABT ? rn : 0; inf[r] = *(const u32x4*)(tokinfo + (size_t)rc * 8); gin[r] = *(const u32x4*)(tokinfo + (size_t)rc * 8 + 4); }
#pragma unroll
        for (int r = 0; r < 2; ++r) { const int rl = rl0 + r * NGW; float ss = 0.f;
#pragma unroll
            for (int j = 0; j < 4; ++j) {
#pragma unroll
#if EOUT_FP8
                for (int k = 0; k < 4; ++k) { const int w = (int)ew[r][j][k]; const f32x2 lo = __builtin_amdgcn_cvt_pk_f32_fp8(w, false), hi2 = __builtin_amdgcn_cvt_pk_f32_fp8(w, true);
                    v[r][j].x += gk[r][k] * lo[0]; v[r][j].y += gk[r][k] * lo[1]; v[r][j].z += gk[r][k] * hi2[0]; v[r][j].w += gk[r][k] * hi2[1]; }
#else
                for (int k = 0; k < 4; ++k) { const u32x2 w = ew[r][j][k]; v[r][j].x += gk[r][k] * bflo(w.x); v[r][j].y += gk[r][k] * bfhi(w.x); v[r][j].z += gk[r][k] * bflo(w.y); v[r][j].w += gk[r][k] * bfhi(w.y); }
#endif
                ss += (v[r][j].x * v[r][j].x + v[r][j].y * v[r][j].y) + (v[r][j].z * v[r][j].z + v[r][j].w * v[r][j].w); }
            const float rs = 1.0f / sqrtf(wave_sum(ss) * (1.f / DM) + 1e-5f);
            if (rl < SLABT) { float* hr = a.out + (size_t)(slab * SLABT + rl) * DM;
#pragma unroll
                for (int j = 0; j < 4; ++j) { const f32x4 o = v[r][j] * rs * gf[j]; if (!dry) *((f32x4*)hr + lane + 64 * j) = o; else if (o[0] == 1.2345e30f) hr[0] = 0.f; } } }
    }
}


#define XB_TMO      128
#define XB_XCNT(j)  (256  + 64 * (j))
#define XB_XSUB(j)  (1280 + 64 * (j))
#define XB_XGEN(j)  (2304 + 64 * (j))
#define XB_TOP      3328
#define XB_TOPGEN   3392
#define XCD_BAR_WORDS 3456
#define XB_SPIN_CAP (1u << 22)
__device__ __forceinline__ unsigned xb_ld(unsigned* p)              { return __hip_atomic_load(p, __ATOMIC_RELAXED, __HIP_MEMORY_SCOPE_AGENT); }
__device__ __forceinline__ unsigned xb_add(unsigned* p, unsigned v) { return __hip_atomic_fetch_add(p, v, __ATOMIC_RELAXED, __HIP_MEMORY_SCOPE_AGENT); }
__device__ __forceinline__ unsigned xb_xcc_id() { return (unsigned)__builtin_amdgcn_s_getreg((3 << 11) | 20) & 0xFu; }
#define XB_SPIN(cond, bar) do { unsigned _sp = 0; while (cond) { __builtin_amdgcn_s_sleep(1); \
    if ((++_sp & 255u) == 0u) { if (xb_ld(&(bar)[XB_TMO])) break; if (_sp > XB_SPIN_CAP) { atomicAdd(&(bar)[XB_TMO], 1u); break; } } } } while (0)
struct XcdBarrier { unsigned* bar; unsigned x; volatile LAS unsigned* st; };
__device__ __forceinline__ XcdBarrier xcd_barrier_post(unsigned* bar, volatile LAS unsigned* st) {
    XcdBarrier b; b.bar = bar; b.x = xb_xcc_id(); b.st = st;
    if (threadIdx.x == 0) (void)xb_add(&bar[XB_XCNT(b.x)], 1u);
    return b;
}
__device__ __forceinline__ void xcd_barrier_complete(unsigned* bar, unsigned x, unsigned& nloc, unsigned& nx) {
    const unsigned G = gridDim.x * gridDim.y * gridDim.z;
    unsigned sum, cnt, mine, sp = 0u;
    for (;;) {
        sum = 0u; cnt = 0u; mine = 0u;
#pragma unroll
        for (unsigned j = 0; j < 16; ++j) { const unsigned c = xb_ld(&bar[XB_XCNT(j)]); sum += c; cnt += (c > 0u) ? 1u : 0u; mine = (j == x) ? c : mine; }
        if (sum == G) break;
        __builtin_amdgcn_s_sleep(1);
        if ((++sp & 255u) == 0u) { if (xb_ld(&bar[XB_TMO])) break; if (sp > XB_SPIN_CAP) { atomicAdd(&bar[XB_TMO], 1u); break; } }
    }
    nloc = mine > 0u ? mine : 1u; nx = cnt > 0u ? cnt : 1u;
}
__device__ __forceinline__ void xcd_barrier(const XcdBarrier& b) {
    asm volatile("s_waitcnt vmcnt(0)" ::: "memory");
    __syncthreads();
    if (threadIdx.x == 0) {
        unsigned* bar = b.bar;
        __builtin_amdgcn_s_waitcnt(0);
        unsigned nloc = b.st[0], nx = b.st[1];
        if (nloc == 0u) { xcd_barrier_complete(bar, b.x, nloc, nx); b.st[0] = nloc; b.st[1] = nx; }
        const unsigned old = xb_add(&bar[XB_XSUB(b.x)], 1u);
        const unsigned gen = old / nloc;
        if (old + 1u == (gen + 1u) * nloc) {
            __builtin_amdgcn_fence(__ATOMIC_RELEASE, "agent");
            asm volatile("s_waitcnt vmcnt(0)" ::: "memory");
            const unsigned og = xb_add(&bar[XB_TOP], 1u);
            const unsigned tg = og / nx;
            if (og + 1u == (tg + 1u) * nx) xb_add(&bar[XB_TOPGEN], 1u);
            else XB_SPIN(xb_ld(&bar[XB_TOPGEN]) == tg, bar);
            __builtin_amdgcn_fence(__ATOMIC_ACQUIRE, "agent");
            xb_add(&bar[XB_XGEN(b.x)], 1u);
            asm volatile("s_waitcnt vmcnt(0)" ::: "memory");
        } else {
            XB_SPIN(xb_ld(&bar[XB_XGEN(b.x)]) == gen, bar);
            __builtin_amdgcn_fence(__ATOMIC_ACQUIRE, "agent");
            asm volatile("s_waitcnt vmcnt(0)" ::: "memory");
        }
    }
    __syncthreads();
}

__device__ __forceinline__ void sub_barrier(unsigned* ctr, unsigned n) {
    asm volatile("s_waitcnt vmcnt(0)" ::: "memory");
    __syncthreads();
    if (threadIdx.x == 0) {
        __builtin_amdgcn_fence(__ATOMIC_RELEASE, "agent");
        asm volatile("s_waitcnt vmcnt(0)" ::: "memory");
        xb_add(ctr, 1u);
        unsigned sp = 0; while (xb_ld(ctr) < n) { __builtin_amdgcn_s_sleep(2); if (++sp > (1u << 24)) break; }
        __builtin_amdgcn_fence(__ATOMIC_ACQUIRE, "agent");
        asm volatile("s_waitcnt vmcnt(0)" ::: "memory");
    }
    __syncthreads();
}

constexpr int NPHASE = 12;
__global__ void __launch_bounds__(NTHR, 2) mega_fwd(Args args) {
    extern __shared__ __attribute__((aligned(16))) unsigned char lds_raw[];
    LAS unsigned char* lds = (LAS unsigned char*)lds_raw;
    const int tid0 = threadIdx.x;
#define OT() ({ int t_ = tid0; asm volatile("" : "+v"(t_)); t_; })
    const int G = gridDim.x, bx = blockIdx.x;
    const int vcu = (G % 8 == 0) ? (bx % 8) * (G / 8) + bx / 8 : bx;
#define KA() args
    unsigned char* ws = args.ws;
    bf16_t* Wt_in = (bf16_t*)(ws + WS_WIN); bf16_t* Wt_out = (bf16_t*)(ws + WS_WOUT); bf16_t* Wt_gu = (bf16_t*)(ws + WS_WGU); bf16_t* Wt_dn = (bf16_t*)(ws + WS_WDN);
    bf16_t* XN = (bf16_t*)(ws + WS_XN); bf16_t* PROJ = (bf16_t*)(ws + WS_PROJ); bf16_t* MIX = (bf16_t*)(ws + WS_MIX);
    bf16_t* ACT = (bf16_t*)(ws + WS_ACT); bf16_t* EOUT = (bf16_t*)(ws + WS_EOUT);
    float* LSE = (float*)(ws + WS_LSE); bf16_t* OPAT = (bf16_t*)KA().out;
    const int lo = KA().ph_lo, hi = KA().ph_hi;
#if MK_MULTI
#define GRID_SYNC() do { } while (0)
#elif USE_CG_SYNC
    cg::grid_group grid = cg::this_grid();
#define GRID_SYNC() grid.sync()
#else
    { volatile LAS unsigned* stw = (volatile LAS unsigned*)(lds + XBST_OFF); if (tid0 < 2) stw[tid0] = 0u; }
    __syncthreads();
    const XcdBarrier xbar = xcd_barrier_post((unsigned*)(ws + WS_CTL) + CW_BAR, (volatile LAS unsigned*)(lds + XBST_OFF));
#define GRID_SYNC() xcd_barrier(xbar)
#endif
#ifndef PHM
#define PHM 0xFFFF
#endif
#define IN(k) (((PHM >> (k)) & 1) && lo <= (k) && (k) < hi)
#define SEAM(k) do { if (IN(k) && IN((k) + 1)) { GRID_SYNC(); } } while (0)
#ifndef PROBE_DUP
#define PROBE_DUP -1
#endif
#ifndef PROBE_SUB
#define PROBE_SUB 0
#endif
#ifndef PROBE_MASK
#define PROBE_MASK 0
#endif
#define REPS(k) for (int rep_ = 0; rep_ < ((PROBE_DUP == (k)) ? 2 : 1); ++rep_, (rep_ < ((PROBE_DUP == (k)) ? 2 : 1) ? (GRID_SYNC(), 0) : 0))

    if (IN(0)) REPS(0) { const int t_ = OT(); phase_prologue(KA(), lds, __builtin_amdgcn_readfirstlane(t_ >> 6), t_ & 63); }
    SEAM(0);
    if (IN(1)) REPS(1) { DenseSched S; S.o.init(MTOK, INW, G, bx); EpiProj E{PROJ}; pg8::gemm_phase<EpiProj, DenseSched>(lds, XN, Wt_in, DM, S, E); }
    SEAM(1);
    if (IN(2)) REPS(2) {
        const int nR = (G >= 256) ? 128 : G / 2;
#ifndef NO_RWKV
        if (bx < nR && !(rep_ == 1 && (PROBE_SUB & 2))) { for (int hd = bx; hd < NB * NH; hd += nR) RWKV_FN(hd >> 3, hd & 7, KA(), PROJ, MIX, lds, OT(), (rep_ == 1) ? (0x80000000u | (unsigned)PROBE_MASK) : 0u); }
#endif
#ifndef NO_ATTN
        if (bx >= nR && !(rep_ == 1 && (PROBE_SUB & 1))) { for (int T = bx - nR; T < 3 * 2048; T += G - nR) attn_task(T, PROJ, OPAT, LSE, lds, OT());
            if (rep_ == 0) {
#if !MK_MULTI
                sub_barrier((unsigned*)(ws + WS_CTL) + CW_SUB, (unsigned)(G - nR));
                phase_merge(OPAT, LSE, MIX, OT(), bx - nR, G - nR);
#endif
                const int t_ = OT(); expert_weight_items(KA(), lds, __builtin_amdgcn_readfirstlane(t_ >> 6), t_ & 63, bx - nR, G - nR); } }
#endif
    }
    SEAM(2);
#if MK_MULTI
    if (IN(3)) REPS(3) { phase_merge(OPAT, LSE, MIX, OT(), bx, G); }
#endif
    if (IN(4)) REPS(4) { DenseSched S; S.o.init(MTOK, DM, G, bx); const Args& A_ = KA(); EpiResid E{A_.in[I_X], A_.out}; pg8::gemm_phase<EpiResid, DenseSched>(lds, MIX, Wt_out, DM, S, E); }
    SEAM(4);
#pragma unroll 1
    for (int slab = 0; slab < NSLAB; ++slab) {
        const int p0 = 5 + 3 * slab;
        unsigned* list = (unsigned*)(ws + WS_LIST) + (size_t)slab * NE * LCAP; float* glist = (float*)(ws + WS_GLIST) + (size_t)slab * NE * LCAP;
        if (slab == 0) { if (IN(5)) { if (PROBE_DUP == 5) { phase_route(0, KA(), lds, OT(), 1); GRID_SYNC(); } phase_route(0, KA(), lds, OT()); } SEAM(5); }
        if (IN(p0 + 1)) REPS(6) { const Args& A_ = KA(); moe_tables(slab, A_, lds, 8, OT());
            constexpr int EB = MOE_FP8_GU ? 1 : 2;
            MoeSched S{(const LAS int*)(lds + MISC_OFF), 8, G, vcu, list, (unsigned)(slab * SLABT), (rep_ == 1 && (PROBE_MASK & 2)) ? 0 : 1, (size_t)2 * DFF * DM * EB, (size_t)256 * DM * EB};
            EpiSwiglu E{ACT, A_.in[I_BGUP], (rep_ == 1) ? (PROBE_MASK | 4) : 0}; pg8::gemm_phase<EpiSwiglu, MoeSched, MOE_FP8_GU != 0>(lds, (const bf16_t*)(ws + WS_XN2), Wt_gu, DM * EB / 2, S, E); }
        SEAM(p0 + 1);
        if (IN(p0 + 2)) REPS(7) { const Args& A_ = KA(); moe_tables(slab, A_, lds, 4, OT());
            constexpr int EB = MOE_FP8_DN ? 1 : 2;
            MoeSched S{(const LAS int*)(lds + MISC_OFF), 4, G, vcu, list, 0u, 0, (size_t)DM * DFF * EB, (size_t)256 * DFF * EB};
            EpiDown E{EOUT, A_.in[I_BDN], (rep_ == 1) ? PROBE_MASK : 0}; pg8::gemm_phase<EpiDown, MoeSched, MOE_FP8_DN != 0>(lds, ACT, Wt_dn, DFF * EB / 2, S, E); }
        SEAM(p0 + 2);
        if (IN(p0 + 3)) { const int t_ = OT(); if (PROBE_DUP == 8) { phase_final(slab, KA(), lds, t_, 1); GRID_SYNC(); } phase_final(slab, KA(), lds, t_); if (slab + 1 < NSLAB) { __syncthreads(); phase_route(slab + 1, KA(), lds, OT()); } }
        if (slab + 1 < NSLAB) SEAM(p0 + 3);
    }
#undef IN
#undef REPS
#undef SEAM
#undef GRID_SYNC
#undef KA
#undef OT
}

extern "C" void kernel_launch(void* const* d_in, const int* in_sizes, int n_in, void* d_out, int out_size, void* d_ws, size_t ws_size, hipStream_t stream) {
    static int grid = 0;
    if (grid == 0) {
        if (n_in != 23 || in_sizes[0] != MTOK * DM || out_size != MTOK * DM || ws_size < WS_NEED) { fprintf(stderr, "kernel_launch: unexpected shapes (n_in %d, in0 %d, out %d, ws %zu)\n", n_in, n_in > 0 ? in_sizes[0] : -1, out_size, ws_size); grid = -1; return; }
        int dev = 0, cus = 0, per_cu = 0;
        if (hipGetDevice(&dev) != hipSuccess || hipDeviceGetAttribute(&cus, hipDeviceAttributeMultiprocessorCount, dev) != hipSuccess) { grid = -1; return; }
        if (hipFuncSetAttribute((const void*)mega_fwd, hipFuncAttributeMaxDynamicSharedMemorySize, LDS_BYTES) != hipSuccess) { fprintf(stderr, "kernel_launch: hipFuncSetAttribute failed\n"); grid = -1; return; }
        if (hipOccupancyMaxActiveBlocksPerMultiprocessor(&per_cu, (const void*)mega_fwd, NTHR, LDS_BYTES) != hipSuccess || per_cu < 1) { fprintf(stderr, "kernel_launch: occupancy query says %d\n", per_cu); per_cu = 1; }
        (void)hipGetLastError();
        grid = cus;
    }
    if (grid < 0) return;
    (void)hipMemsetAsync((char*)d_ws + WS_CTL, 0, CTL_BYTES, stream);
    Args a{};
    for (int i = 0; i < 23; ++i) a.in[i] = (const float*)d_in[i];
    a.out = (float*)d_out; a.ws = (unsigned char*)d_ws;
#if MK_MULTI
    for (int p = 0; p < NPHASE; ++p) { a.ph_lo = p; a.ph_hi = p + 1; hipLaunchKernelGGL(mega_fwd, dim3(grid), dim3(NTHR), LDS_BYTES, stream, a); }
#else
    a.ph_lo = 0; a.ph_hi = NPHASE;
    void* kargs[] = {&a};
    hipError_t e = hipLaunchCooperativeKernel((const void*)mega_fwd, dim3(grid), dim3(NTHR), kargs, LDS_BYTES, stream);
    if (e != hipSuccess) fprintf(stderr, "kernel_launch: cooperative launch failed: %s (grid %d)\n", hipGetErrorString(e), grid);
#endif
}
```

```cpp
#include <hip/hip_runtime.h>
#include <hip/hip_cooperative_groups.h>
#include <cstdio>
#include <cstdint>
namespace cg = cooperative_groups;

#ifndef WO_FUSED
#define WO_FUSED 1
#endif
#ifndef ATTN_QKV8
#define ATTN_QKV8 1
#endif
#ifndef MOE_FP8_GU
#define MOE_FP8_GU 1
#endif
#ifndef MOE_FP8_DN
#define MOE_FP8_DN 1
#endif
#ifndef EOUT_FP8
#define EOUT_FP8 1
#endif
#ifndef RWKV_CHUNKED
#define RWKV_CHUNKED 1
#endif
#if RWKV_CHUNKED
#define RWKV_FN rwkv_head_chunked
#else
#define RWKV_FN rwkv_head
#endif
#ifndef USE_CG_SYNC
#define USE_CG_SYNC 0
#endif
#ifndef MK_MULTI
#define MK_MULTI 0
#endif

#define LAS __attribute__((address_space(3)))
typedef unsigned short bf16_t;
typedef short bf16x8 __attribute__((ext_vector_type(8)));
typedef short s16x4 __attribute__((ext_vector_type(4)));
typedef float f32x2 __attribute__((ext_vector_type(2)));
typedef float f32x4 __attribute__((ext_vector_type(4)));
typedef float f32x16 __attribute__((ext_vector_type(16)));
typedef unsigned u32x4 __attribute__((ext_vector_type(4)));
typedef unsigned u32x2 __attribute__((ext_vector_type(2)));
typedef int i32x4 __attribute__((ext_vector_type(4)));
typedef int i32x8 __attribute__((ext_vector_type(8)));

constexpr int NB = 16, SEQ = 4096, DM = 1024, MTOK = NB * SEQ;
constexpr int INW = 3328, NH = 8, HD = 64;
constexpr int NE = 32, DFF = 1024;
#ifndef MOE_NSLAB
#define MOE_NSLAB 1
#endif
constexpr int NSLAB = MOE_NSLAB, SLABT = MTOK / NSLAB;
constexpr int LCAP = SLABT;
constexpr int ACT_ROWS = SLABT * 4 + NE * 256;
constexpr int NWAVES = 8, NTHR = 512;
constexpr int LDS_BYTES = 163840;
constexpr int GEMM_LDS = 131072, MISC_OFF = 131072, BIAS_OFF = MISC_OFF + 2048, XBST_OFF = LDS_BYTES - 64;

constexpr size_t MiB = 1u << 20;
constexpr size_t WS_CTL = 0, CTL_BYTES = 64 * 1024;
constexpr size_t WS_WIN = 1 * MiB, WS_WOUT = 8 * MiB, WS_WGU = 10 * MiB, WS_WDN = 138 * MiB;
constexpr size_t WS_WRT = 7 * MiB + 512 * 1024;
constexpr size_t WS_ONES = 7 * MiB + 768 * 1024;
constexpr size_t WS_LORA = 170 * MiB;
constexpr size_t WS_LIST = 202 * MiB, WS_GLIST = 210 * MiB, WS_LSE = 218 * MiB;
constexpr size_t WS_XN = 224 * MiB, WS_PROJ = 352 * MiB, WS_MIX = 224 * MiB, WS_END = 896 * MiB;
constexpr size_t WS_XN2 = (NSLAB == 1) ? 74 * MiB : WS_XN;
constexpr size_t WS_ACT = (NSLAB == 1) ? 224 * MiB : 352 * MiB, WS_EOUT = (NSLAB == 1) ? 488 * MiB : 624 * MiB;
constexpr size_t WS_QKV8 = 768 * MiB;
constexpr size_t WS_H16 = 768 * MiB;
constexpr size_t WS_NEED = (NSLAB == 1) ? 896 * MiB : WS_END;
static_assert(WS_ACT + (size_t)ACT_ROWS * DFF * (MOE_FP8_DN ? 1 : 2) <= WS_EOUT && WS_EOUT + (size_t)ACT_ROWS * DM * (EOUT_FP8 ? 1 : 2) <= WS_H16 && NSLAB == 1 && (NSLAB != 1 || (MOE_FP8_GU && MOE_FP8_DN)), "ws map");
constexpr int CW_CNT = 1024, CW_BAR = 4096, CW_SUB = 8192, CW_CONV = 8256, CW_SUB2 = 8320, CW_MDONE = 8384, CW_TILE = 8448, CW_PROG = 8512, CW_HDONE = 8768, CW_RCLAIM = 9024;

struct Args { const float* in[23]; float* out; unsigned char* ws; int ph_lo, ph_hi; };
enum { I_X = 0, I_GMIX, I_WIN, I_MU, I_W0, I_WDU, I_A0, I_WIU, I_WGU, I_KK, I_KA, I_RK, I_GNW, I_GNB, I_WOUT, I_GFFN, I_WR, I_BR, I_WGUP, I_BGUP, I_WDN, I_BDN, I_GFIN };

typedef __bf16 bf16x2_t __attribute__((ext_vector_type(2)));
__device__ __forceinline__ unsigned pk2(float lo, float hi) { f32x2 v = {lo, hi}; bf16x2_t b = __builtin_convertvector(v, bf16x2_t); return __builtin_bit_cast(unsigned, b); }
__device__ __forceinline__ unsigned f2bf(float f) { return pk2(f, f) & 0xffffu; }
__device__ __forceinline__ float bf2f(unsigned short b) { return __builtin_bit_cast(float, (unsigned)b << 16); }
__device__ __forceinline__ float bflo(unsigned w) { return __builtin_bit_cast(float, w << 16); }
__device__ __forceinline__ float bfhi(unsigned w) { return __builtin_bit_cast(float, w & 0xffff0000u); }
template <int CTRL> __device__ __forceinline__ float dpp_f(float v) { return __builtin_bit_cast(float, __builtin_amdgcn_update_dpp(0, __builtin_bit_cast(int, v), CTRL, 0xF, 0xF, true)); }
__device__ __forceinline__ float sum8(float v) { v += dpp_f<0xB1>(v); v += dpp_f<0x4E>(v); v += dpp_f<0x141>(v); return v; }
template <int CTRL, int RMASK> __device__ __forceinline__ float dpp_rm(float v) { return __builtin_bit_cast(float, __builtin_amdgcn_update_dpp(0, __builtin_bit_cast(int, v), CTRL, RMASK, 0xF, false)); }
__device__ __forceinline__ float scan64(float v) {
    v += dpp_f<0x111>(v); v += dpp_f<0x112>(v); v += dpp_f<0x114>(v); v += dpp_f<0x118>(v);
    v += dpp_rm<0x142, 0xA>(v); v += dpp_rm<0x143, 0xC>(v);
    return v;
}
__device__ __forceinline__ float sum16(float v) { v = sum8(v); v += dpp_f<0x140>(v); return v; }
__device__ __forceinline__ float wave_sum(float v) {
    v = sum16(v);
    const float a = __builtin_bit_cast(float, __builtin_amdgcn_readlane(__builtin_bit_cast(int, v), 0)), b = __builtin_bit_cast(float, __builtin_amdgcn_readlane(__builtin_bit_cast(int, v), 16));
    const float c = __builtin_bit_cast(float, __builtin_amdgcn_readlane(__builtin_bit_cast(int, v), 32)), d = __builtin_bit_cast(float, __builtin_amdgcn_readlane(__builtin_bit_cast(int, v), 48));
    return (a + b) + (c + d);
}
__device__ __forceinline__ float sigmoidf_(float x) { return 1.0f / (1.0f + __expf(-x)); }
__device__ __forceinline__ unsigned pk4_fp8(float a, float b, float c, float d) { int w = 0; w = __builtin_amdgcn_cvt_pk_fp8_f32(a, b, w, false); w = __builtin_amdgcn_cvt_pk_fp8_f32(c, d, w, true); return (unsigned)w; }
#define LDS_WAIT() asm volatile("s_waitcnt lgkmcnt(0)" ::: "memory")

namespace pg8 {
constexpr int BM = 256, BK = 64, HALF = 128, HTB = HALF * BK * 2, NXCD = 8, WGM = 4;
__device__ __forceinline__ int lds_byte(int r, int c) { const int st = (r >> 4) * 2 + (c >> 5), rr = r & 15, cc = c & 31, ob = rr * 64 + cc * 2; return st * 1024 + (ob ^ (((ob >> 9) & 1) << 5)); }
__device__ __forceinline__ void stage_rc(int b, int& R, int& C) { const int st = b / 1024, sb = b % 1024, swz = sb ^ (((sb >> 9) & 1) << 5); R = (st >> 1) * 16 + swz / 64; C = (st & 1) * 32 + (swz % 64) / 2; }
__device__ __forceinline__ int perm32(int rho) { const int n = rho >> 4, i = rho & 15; return 8 * (i >> 2) + 4 * n + (i & 3); }

struct Unit { int pm, pn, e, cnt, rbase, slot; };

struct DenseOrder {
    int nM, nN, nwg, G, c;
    __device__ void init(int M, int N, int G_, int c_) { nM = M / BM; nN = N / BM; nwg = nM * nN; G = G_; c = c_; }
    __device__ bool next(int i, Unit& u) const {
        const long L = (long)i * G + c; if (L >= nwg) return false;
        int wgid = (int)L; { const int q = nwg / NXCD, r = nwg % NXCD, xcd = wgid % NXCD, off = wgid / NXCD; wgid = (xcd < r ? xcd * (q + 1) : r * (q + 1) + (xcd - r) * q) + off; }
        const int nig = WGM * nN, gid = wgid / nig, fm = gid * WGM, gsz = (nM - fm) < WGM ? (nM - fm) : WGM;
        u.pm = fm + ((wgid % nig) % gsz); u.pn = (wgid % nig) / gsz; u.e = 0; u.cnt = 0; u.rbase = 0; return true;
    }
};

__device__ __forceinline__ unsigned cvt_pk_bf16(float lo, float hi) { unsigned r; asm volatile("v_cvt_pk_bf16_f32 %0, %1, %2" : "=v"(r) : "v"(lo), "v"(hi)); return r; }

template <class Epi, class Sched, bool FP8 = false>
__device__ __forceinline__ void gemm_phase(LAS unsigned char* lds, const bf16_t* A, const bf16_t* Bt, const int K, const Sched& S, const Epi& E) {
    int tid = threadIdx.x; asm volatile("" : "+v"(tid));
    const int wid = __builtin_amdgcn_readfirstlane(tid >> 6), lane = tid & 63, wr = wid >> 2, wc = wid & 3, fr = lane & 15, fq = lane >> 4;
    const int nt = K / BK;
    unsigned voffB[2];
#pragma unroll
    for (int i = 0; i < 2; ++i) { int R, C; stage_rc(tid * 16 + i * 8192, R, C); const int Rb = Epi::PERM ? ((R & ~31) + perm32(R & 31)) : R; voffB[i] = (unsigned)(Rb * K + C) * 2u; }
#define PG8_RC(i_) int t2_ = tid; asm volatile("" : "+v"(t2_)); int R_, C_; stage_rc(t2_ * 16 + (i_) * 8192, R_, C_)
    const size_t kstep = (size_t)(BK * 2);
    const size_t hstep = (size_t)HALF * K * 2;
    const unsigned ldsw = (unsigned)wid * 1024u;
    const int aoff = lds_byte(wr * 64 + fr, fq * 8), boff = lds_byte(wc * 32 + fr, fq * 8);
#define PG8_SA(b, h) (((b) * 2 + (h)) * HTB)
#define PG8_SB(b, h) ((4 + (b) * 2 + (h)) * HTB)
#define PG8_STAGE(bufoff, gbase, voff) do { _Pragma("unroll") for (int _i = 0; _i < 2; ++_i) \
        __builtin_amdgcn_global_load_lds((const unsigned*)((const char*)(gbase) + (voff)[_i]), (LAS unsigned*)(lds + (bufoff) + ldsw + _i * 8192), 16, 0, 0); } while (0)
#define PG8_LDA(dst, b, h) do { _Pragma("unroll") for (int m = 0; m < 4; ++m) _Pragma("unroll") for (int k = 0; k < 2; ++k) dst[m][k] = *(const LAS bf16x8*)(lds + PG8_SA(b, h) + aoff + m * 2048 + k * 1024); } while (0)
#define PG8_LDB(dst, b, h) do { _Pragma("unroll") for (int n = 0; n < 2; ++n) _Pragma("unroll") for (int k = 0; k < 2; ++k) dst[n][k] = *(const LAS bf16x8*)(lds + PG8_SB(b, h) + boff + n * 2048 + k * 1024); } while (0)
#define PG8_MMA(ai, bj, At, Bt_) do { __builtin_amdgcn_s_setprio(1); \
        if constexpr (FP8) { _Pragma("unroll") for (int m = 0; m < 4; ++m) _Pragma("unroll") for (int n = 0; n < 2; ++n) { \
            const i32x8 bw_ = __builtin_shufflevector(__builtin_bit_cast(i32x4, Bt_[n][0]), __builtin_bit_cast(i32x4, Bt_[n][1]), 0, 1, 2, 3, 4, 5, 6, 7); \
            const i32x8 aw_ = __builtin_shufflevector(__builtin_bit_cast(i32x4, At[m][0]), __builtin_bit_cast(i32x4, At[m][1]), 0, 1, 2, 3, 4, 5, 6, 7); \
            asm volatile("v_mfma_scale_f32_16x16x128_f8f6f4 %0, %1, %2, %0, %3, %4 op_sel_hi:[0,0,0]" : "+v"(acc[ai][bj][m][n]) : "v"(bw_), "v"(aw_), "v"(sc_w8), "v"(sc_a8)); } } \
        else { _Pragma("unroll") for (int m = 0; m < 4; ++m) _Pragma("unroll") for (int n = 0; n < 2; ++n) _Pragma("unroll") for (int k = 0; k < 2; ++k) \
            acc[ai][bj][m][n] = __builtin_amdgcn_mfma_f32_16x16x32_bf16(Bt_[n][k], At[m][k], acc[ai][bj][m][n], 0, 0, 0); } \
        __builtin_amdgcn_s_setprio(0); } while (0)
#define PG8_WAIT_V(n) asm volatile("s_waitcnt vmcnt(" #n ")" ::: "memory")
#define PG8_WAIT_VS_(sv, N) asm volatile("s_cmp_lg_u32 %0, 0\n\ts_cbranch_scc1 1f\n\ts_waitcnt vmcnt(8)\n1:\n\ts_waitcnt vmcnt(" #N ")" :: "s"(sv) : "memory", "scc")
#define PG8_WAIT_VS(sv) do { if constexpr (Epi::NS == 16) PG8_WAIT_VS_(sv, 24); else if constexpr (Epi::NS == 12) PG8_WAIT_VS_(sv, 20); else if constexpr (Epi::NS == 8) PG8_WAIT_VS_(sv, 16); else PG8_WAIT_V(8); } while (0)
#define PG8_WAIT_L(n) asm volatile("s_waitcnt lgkmcnt(" #n ")" ::: "memory")
#define PG8_BAR __builtin_amdgcn_s_barrier()
#define PG8_BIAS(u_, sl_) do { if constexpr (Epi::LB) { int tb_ = tid; asm volatile("" : "+v"(tb_)); \
        __builtin_amdgcn_global_load_lds((const unsigned*)E.bias_addr(u_, (wid & 3) * 64 + (tb_ & 63)), (LAS unsigned*)(lds + BIAS_OFF + (sl_) * 1024 + (wid & 3) * 256), 4, 0, 0); } } while (0)
#define PG8_SCHED __builtin_amdgcn_sched_barrier(0)
    Unit cur, nxt; int ui = 0;
    if (!S.next(0, cur)) return;
    cur.slot = 0; PG8_BIAS(cur, 0);
#define PG8_ENT(u_) do { _Pragma("unroll") for (int i = 0; i < 2; ++i) { PG8_RC(i); (void)C_; ent_n[2 * i] = S.a_ent(u_, R_); ent_n[2 * i + 1] = S.a_ent(u_, HALF + R_); } } while (0)
    bool hn_c = false; unsigned ent_n[4] = {0u, 0u, 0u, 0u};
    if constexpr (Sched::PRE) { hn_c = S.next(1, nxt); if (hn_c) PG8_ENT(nxt); }
    f32x4 acc[2][2][4][2];
#pragma unroll
    for (int a = 0; a < 2; ++a)
#pragma unroll
        for (int b = 0; b < 2; ++b)
#pragma unroll
            for (int m = 0; m < 4; ++m)
#pragma unroll
                for (int n = 0; n < 2; ++n) { f32x2 z0_, z1_; asm volatile("v_pk_mov_b32 %0, 0, 0" : "=v"(z0_)); asm volatile("v_pk_mov_b32 %0, 0, 0" : "=v"(z1_)); acc[a][b][m][n] = __builtin_shufflevector(z0_, z1_, 0, 1, 2, 3); }
    bf16x8 At[4][2], B0[2][2], B1[2][2];
    int sc_w8 = 0x7A7A7A7A, sc_a8 = 0x7F7F7F7F;
    asm volatile("" : "+v"(sc_w8), "+v"(sc_a8));
    unsigned cvA0[2], cvA1[2], nvA0[2], nvA1[2];
#pragma unroll
    for (int i = 0; i < 2; ++i) { PG8_RC(i); cvA0[i] = (S.a_row(cur, R_) * (unsigned)K + (unsigned)C_) * 2u; cvA1[i] = (S.a_row(cur, HALF + R_) * (unsigned)K + (unsigned)C_) * 2u; }
    const char* A8 = (const char*)A;
    const char* cB = (const char*)Bt + S.b_off(cur);
    PG8_STAGE(PG8_SB(0, 0), cB, voffB); PG8_STAGE(PG8_SB(0, 1), cB + hstep, voffB); PG8_STAGE(PG8_SA(0, 0), A8, cvA0); PG8_STAGE(PG8_SA(0, 1), A8, cvA1);
    if (wr == 1) PG8_BAR;
    PG8_WAIT_V(2); PG8_BAR;
    PG8_STAGE(PG8_SB(1, 0), cB + kstep, voffB); PG8_STAGE(PG8_SA(1, 0), A8 + kstep, cvA0); PG8_STAGE(PG8_SB(1, 1), cB + hstep + kstep, voffB);
    PG8_WAIT_V(6); PG8_BAR;
    for (;;) {
        bool has_next; if constexpr (Sched::PRE) has_next = hn_c; else has_next = S.next(ui + 1, nxt);
        if constexpr (Sched::PRE) { asm volatile("s_waitcnt vmcnt(%0)" :: "n"(Epi::NS) : "memory");
            asm volatile("" : "+v"(ent_n[0]), "+v"(ent_n[1]), "+v"(ent_n[2]), "+v"(ent_n[3])); }
        const char* nB = has_next ? (const char*)Bt + S.b_off(nxt) : cB;
        if (has_next) {
#pragma unroll
            for (int i = 0; i < 2; ++i) { PG8_RC(i);
                if constexpr (Sched::PRE) { nvA0[i] = (S.a_row_e(nxt, R_, ent_n[2 * i]) * (unsigned)K + (unsigned)C_) * 2u; nvA1[i] = (S.a_row_e(nxt, HALF + R_, ent_n[2 * i + 1]) * (unsigned)K + (unsigned)C_) * 2u; }
                else { nvA0[i] = (S.a_row(nxt, R_) * (unsigned)K + (unsigned)C_) * 2u; nvA1[i] = (S.a_row(nxt, HALF + R_) * (unsigned)K + (unsigned)C_) * 2u; } }
        } else {
#pragma unroll
            for (int i = 0; i < 2; ++i) { nvA0[i] = cvA0[i]; nvA1[i] = cvA1[i]; }
        }
        for (int t = 0; t < nt; t += 2) {
            const bool last = (t == nt - 2);
            const char* a1 = A8 + (size_t)(t + 1) * kstep;
            const char* a2 = last ? A8 : A8 + (size_t)(t + 2) * kstep; const char* b2 = last ? nB : cB + (size_t)(t + 2) * kstep;
            const char* a3 = a2 + kstep; const char* b3 = b2 + kstep;
            unsigned xA0[2], xA1[2];
#pragma unroll
            for (int i = 0; i < 2; ++i) { xA0[i] = last ? nvA0[i] : cvA0[i]; xA1[i] = last ? nvA1[i] : cvA1[i]; }
            const int seam = __builtin_amdgcn_readfirstlane((ui > 0 && t == 0) ? 1 : 0);
            PG8_LDB(B0, 0, 0); PG8_LDB(B1, 0, 1); PG8_SCHED; PG8_LDA(At, 0, 0); PG8_STAGE(PG8_SA(1, 1), a1, cvA1);
            PG8_WAIT_VS(seam); PG8_WAIT_L(0); PG8_BAR; PG8_MMA(0, 0, At, B0); PG8_MMA(0, 1, At, B1); PG8_BAR; PG8_SCHED;
            PG8_LDA(At, 0, 1); PG8_STAGE(PG8_SB(0, 0), b2, voffB); PG8_STAGE(PG8_SB(0, 1), b2 + hstep, voffB); PG8_STAGE(PG8_SA(0, 0), a2, xA0);
            PG8_WAIT_VS(seam); PG8_WAIT_L(0); PG8_BAR; PG8_MMA(1, 0, At, B0); PG8_MMA(1, 1, At, B1); PG8_BAR; PG8_SCHED;
            PG8_LDB(B0, 1, 0); PG8_LDB(B1, 1, 1); PG8_SCHED; PG8_LDA(At, 1, 0); PG8_STAGE(PG8_SA(0, 1), a2, xA1);
            PG8_WAIT_V(8); PG8_WAIT_L(0); PG8_BAR; PG8_MMA(0, 0, At, B0); PG8_MMA(0, 1, At, B1); PG8_BAR; PG8_SCHED;
            PG8_LDA(At, 1, 1); PG8_STAGE(PG8_SB(1, 0), b3, voffB); PG8_STAGE(PG8_SB(1, 1), b3 + hstep, voffB); PG8_STAGE(PG8_SA(1, 0), a3, xA0);
            PG8_WAIT_V(8); PG8_WAIT_L(0); PG8_BAR; PG8_MMA(1, 0, At, B0); PG8_MMA(1, 1, At, B1); PG8_BAR; PG8_SCHED;
        }
        if (wr == 0) PG8_BAR;
        Unit nn = nxt; bool has_nn = false;
        if (has_next) { nxt.slot = (ui + 1) & 1; PG8_BIAS(nxt, nxt.slot);
            if constexpr (Sched::PRE) { has_nn = S.next(ui + 2, nn); if (has_nn) PG8_ENT(nn); } }
        E(acc, cur, wr, wc, fr, fq);
        if (!has_next) break;
#pragma unroll
        for (int a = 0; a < 2; ++a)
#pragma unroll
            for (int b = 0; b < 2; ++b)
#pragma unroll
                for (int m = 0; m < 4; ++m)
#pragma unroll
                    for (int n = 0; n < 2; ++n) { f32x2 z0_, z1_; asm volatile("v_pk_mov_b32 %0, 0, 0" : "=v"(z0_)); asm volatile("v_pk_mov_b32 %0, 0, 0" : "=v"(z1_)); acc[a][b][m][n] = __builtin_shufflevector(z0_, z1_, 0, 1, 2, 3); }
        cur = nxt; cB = nB; ++ui;
        if constexpr (Sched::PRE) { nxt = nn; hn_c = has_nn; }
#pragma unroll
        for (int i = 0; i < 2; ++i) { cvA0[i] = nvA0[i]; cvA1[i] = nvA1[i]; }
        if (wr == 1) PG8_BAR;
    }
    PG8_WAIT_V(0);
    PG8_BAR;
#undef PG8_RC
#undef PG8_SA
#undef PG8_SB
#undef PG8_STAGE
#undef PG8_LDA
#undef PG8_LDB
#undef PG8_MMA
#undef PG8_WAIT_V
#undef PG8_WAIT_VS
#undef PG8_WAIT_VS_
#undef PG8_WAIT_L
#undef PG8_BAR
#undef PG8_BIAS
#undef PG8_ENT
#undef PG8_SCHED
}
}

struct DenseSched {
    static constexpr bool PRE = false;
    pg8::DenseOrder o;
    __device__ __forceinline__ bool next(int i, pg8::Unit& u) const { return o.next(i, u); }
    __device__ __forceinline__ size_t b_off(const pg8::Unit& u) const { return (size_t)u.pn * 256 * DM * 2; }
    __device__ __forceinline__ unsigned a_row(const pg8::Unit& u, int r) const { return (unsigned)(u.pm * 256 + r); }
};
struct MoeSched {
    static constexpr bool PRE = true;
    const LAS int* tab;
    int nNt, G, vc; const unsigned* list; unsigned tokbase; int gather; size_t estride, tstride;
    __device__ __forceinline__ bool next(int i, pg8::Unit& u) const {
        const int L = i * G + vc; const int total = tab[32]; if (L >= total) return false;
        const int ln = (int)(threadIdx.x & 63u), l5 = ln & 31;
        const int pv = tab[l5], cv = tab[64 + l5], rv = tab[128 + l5];
        const unsigned long long mk = __ballot(ln < 32 && pv <= L);
        const int e = 63 - __builtin_clzll(mk);
        const int loc = L - __builtin_amdgcn_readlane(pv, e); u.e = e; u.pm = loc / nNt; u.pn = loc % nNt; u.cnt = __builtin_amdgcn_readlane(cv, e); u.rbase = __builtin_amdgcn_readlane(rv, e); return true;
    }
    __device__ __forceinline__ size_t b_off(const pg8::Unit& u) const { return (size_t)u.e * estride + (size_t)u.pn * tstride; }
    __device__ __forceinline__ unsigned a_row(const pg8::Unit& u, int r) const {
        const int pos = u.pm * 256 + r;
        if (gather) { unsigned ent = 0; if (pos < u.cnt) ent = list[(size_t)u.e * LCAP + pos]; return tokbase + (ent >> 2); }
        return (unsigned)(u.rbase + pos);
    }
    __device__ __forceinline__ unsigned a_ent(const pg8::Unit& u, int r) const { const int pos = u.pm * 256 + r; unsigned ent = 0; if (gather) { const unsigned* p_ = list + (size_t)u.e * LCAP + (pos < u.cnt ? pos : 0); asm volatile("global_load_dword %0, %1, off" : "=v"(ent) : "v"(p_) : "memory"); } return ent; }
    __device__ __forceinline__ unsigned a_row_e(const pg8::Unit& u, int r, unsigned ent) const { const int pos = u.pm * 256 + r; if (gather) return tokbase + ((pos < u.cnt ? ent : 0u) >> 2); return (unsigned)(u.rbase + pos); }
};

struct EpiProj {
    static constexpr bool LB = false; static constexpr bool PERM = true; static constexpr int NS = 16; bf16_t* O; int alias = 0; unsigned char* O8 = nullptr;
    __device__ __forceinline__ void operator()(const f32x4 (&acc)[2][2][4][2], const pg8::Unit& u, int wr, int wc, int fr, int fq) const {
        const int row0 = alias ? (int)blockIdx.x * 64 + fr : u.pm * 256 + wr * 64 + fr, col0 = alias ? wc * 32 + 8 * fq : u.pn * 256 + wc * 32 + 8 * fq;
#if ATTN_QKV8
        if (O8 != nullptr && u.pn < 6 && !alias) {
#pragma unroll
            for (int ai = 0; ai < 2; ++ai)
#pragma unroll
                for (int m = 0; m < 4; ++m) { unsigned char* rowp = O8 + (size_t)(row0 + ai * 128 + m * 16) * 1536 + col0;
#pragma unroll
                    for (int bj = 0; bj < 2; ++bj) { const f32x4 v0 = acc[ai][bj][m][0], v1 = acc[ai][bj][m][1]; u32x2 w; w.x = pk4_fp8(v0[0], v0[1], v0[2], v0[3]); w.y = pk4_fp8(v1[0], v1[1], v1[2], v1[3]);
                        *(u32x2*)(rowp + bj * 128) = w; } }
            return; }
#endif
#pragma unroll
        for (int ai = 0; ai < 2; ++ai)
#pragma unroll
            for (int m = 0; m < 4; ++m) { bf16_t* rowp = O + (size_t)(row0 + (alias ? ((ai * 128 + m * 16) & 63) : ai * 128 + m * 16)) * INW + col0;
#pragma unroll
                for (int bj = 0; bj < 2; ++bj) { const f32x4 v0 = acc[ai][bj][m][0], v1 = acc[ai][bj][m][1]; u32x4 w;
                    w.x = pg8::cvt_pk_bf16(v0[0], v0[1]); w.y = pg8::cvt_pk_bf16(v0[2], v0[3]); w.z = pg8::cvt_pk_bf16(v1[0], v1[1]); w.w = pg8::cvt_pk_bf16(v1[2], v1[3]);
#ifdef PROBE_COAL
                    if (alias) { *(u32x4*)(O + ((size_t)blockIdx.x * 8 + (threadIdx.x >> 6)) * 8192 + (size_t)((ai * 4 + m) * 2 + bj) * 512 + (threadIdx.x & 63) * 8) = w; continue; }
#endif
#ifdef PROBE_HALF
                    if (alias && bj) continue;
#endif
#ifdef PROBE_XCDHALF
                    if (alias && ((blockIdx.x & 7) >= 4)) continue;
#endif
#ifdef PROBE_EVEN
                    if (alias && (blockIdx.x & 1)) continue;
#endif
#ifdef PROBE_X2
                    if (alias) { u32x2 w2; w2.x = w.x; w2.y = w.z; *(u32x2*)(rowp + bj * 128) = w2; continue; }
#endif
#ifdef STORE_SC1
                    { const bf16_t* p_ = rowp + bj * 128; asm volatile("global_store_dwordx4 %0, %1, off " STORE_SC1 "\n\ts_nop 0" :: "v"(p_), "v"(w) : "memory"); }
#else
                    *(u32x4*)(rowp + bj * 128) = w;
#endif
                } }
    }
};
struct EpiResid {
    static constexpr bool LB = false; static constexpr bool PERM = true; static constexpr int NS = 12; const float* X; bf16_t* H; float* HS2;
    __device__ __forceinline__ void operator()(const f32x4 (&acc)[2][2][4][2], const pg8::Unit& u, int wr, int wc, int fr, int fq) const {
        const int row0 = u.pm * 256 + wr * 64 + fr, col0 = u.pn * 256 + wc * 32 + 8 * fq;
#pragma unroll
        for (int ai = 0; ai < 2; ++ai) {
            f32x4 xv[4][2][2];
#pragma unroll
            for (int m = 0; m < 4; ++m) { const size_t off = (size_t)(row0 + ai * 128 + m * 16) * DM + col0;
#pragma unroll
                for (int bj = 0; bj < 2; ++bj) { xv[m][bj][0] = *(const f32x4*)(X + off + bj * 128); xv[m][bj][1] = *(const f32x4*)(X + off + bj * 128 + 4); } }
#pragma unroll
            for (int m = 0; m < 4; ++m) asm volatile("" : "+v"(xv[m][0][0]), "+v"(xv[m][0][1]), "+v"(xv[m][1][0]), "+v"(xv[m][1][1]));
#pragma unroll
            for (int m = 0; m < 4; ++m) { const size_t off = (size_t)(row0 + ai * 128 + m * 16) * DM + col0; float s2 = 0.f;
#pragma unroll
                for (int bj = 0; bj < 2; ++bj) { const f32x4 h0 = xv[m][bj][0] + acc[ai][bj][m][0], h1 = xv[m][bj][1] + acc[ai][bj][m][1];
                    s2 += ((h0[0] * h0[0] + h0[1] * h0[1]) + (h0[2] * h0[2] + h0[3] * h0[3])) + ((h1[0] * h1[0] + h1[1] * h1[1]) + (h1[2] * h1[2] + h1[3] * h1[3]));
                    u32x4 w; w.x = pg8::cvt_pk_bf16(h0[0], h0[1]); w.y = pg8::cvt_pk_bf16(h0[2], h0[3]); w.z = pg8::cvt_pk_bf16(h1[0], h1[1]); w.w = pg8::cvt_pk_bf16(h1[2], h1[3]);
                    { const bf16_t* hp_ = H + off + bj * 128; asm volatile("global_store_dwordx4 %0, %1, off sc1\n\ts_nop 1" :: "v"(hp_), "v"(w) : "memory"); } }
                s2 += __shfl_xor(s2, 16); s2 += __shfl_xor(s2, 32);
                if (fq == 0) { const float* sp_ = HS2 + (size_t)(row0 + ai * 128 + m * 16) * 16 + u.pn * 4 + wc; asm volatile("global_store_dword %0, %1, off sc1\n\ts_nop 1" :: "v"(sp_), "v"(s2) : "memory"); } } }
    }
};
struct EpiSwiglu {
    static constexpr bool LB = true; static constexpr bool PERM = true; static constexpr int NS = 8; bf16_t* ACT; const float* bgu; int dry; LAS const unsigned char* lb;
    __device__ __forceinline__ const float* bias_addr(const pg8::Unit& u, int idx) const { return bgu + (size_t)u.e * 2 * DFF + u.pn * 128 + (idx & 127) + (idx >> 7) * DFF; }
    __device__ __forceinline__ void operator()(const f32x4 (&acc)[2][2][4][2], const pg8::Unit& u, int wr, int wc, int fr, int fq) const {
        if (dry & 1) return;
        const int f0 = u.pn * 128 + wc * 32 + 8 * fq; const LAS float* bl = (const LAS float*)(lb + u.slot * 1024) + wc * 32 + 8 * fq;
        f32x4 bg[2], bu[2];
#pragma unroll
        for (int n = 0; n < 2; ++n) { bg[n] = *(const LAS f32x4*)(bl + 4 * n); bu[n] = *(const LAS f32x4*)(bl + 128 + 4 * n) + 1.0f; }
#pragma unroll
        for (int ai = 0; ai < 2; ++ai)
#pragma unroll
            for (int m = 0; m < 4; ++m) { const int pos = u.pm * 256 + ai * 128 + wr * 64 + m * 16 + fr;
                float a[8];
#pragma unroll
                for (int n = 0; n < 2; ++n) { const f32x4 g = acc[ai][0][m][n] + bg[n], up = acc[ai][1][m][n] + bu[n];
#pragma unroll
                    for (int x = 0; x < 4; x += 2) {
                        typedef float f32x2_ __attribute__((ext_vector_type(2)));
                        f32x2_ gl, ul; gl.x = fminf(g[x], 7.0f); gl.y = fminf(g[x + 1], 7.0f); ul.x = fminf(fmaxf(up[x], -6.0f), 8.0f); ul.y = fminf(fmaxf(up[x + 1], -6.0f), 8.0f);
                        const f32x2_ t2 = gl * (f32x2_){-2.4554669595930156f, -2.4554669595930156f};
                        f32x2_ e2; e2.x = __builtin_amdgcn_exp2f(t2.x); e2.y = __builtin_amdgcn_exp2f(t2.y);
                        const f32x2_ d2 = e2 + (f32x2_){1.0f, 1.0f};
                        f32x2_ r2; r2.x = __builtin_amdgcn_rcpf(d2.x); r2.y = __builtin_amdgcn_rcpf(d2.y);
                        const f32x2_ o2 = ul * (gl * r2);
                        a[4 * n + x] = o2.x; a[4 * n + x + 1] = o2.y; } }
#if MOE_FP8_DN
                if (!(dry & 4)) { u32x2 w; w.x = pk4_fp8(a[0], a[1], a[2], a[3]); w.y = pk4_fp8(a[4], a[5], a[6], a[7]); *(u32x2*)((unsigned char*)ACT + (size_t)(u.rbase + pos) * DFF + f0) = w; } }
#else
                if (pos < u.cnt) { u32x4 w; w.x = pg8::cvt_pk_bf16(a[0], a[1]); w.y = pg8::cvt_pk_bf16(a[2], a[3]); w.z = pg8::cvt_pk_bf16(a[4], a[5]); w.w = pg8::cvt_pk_bf16(a[6], a[7]);
                    *(u32x4*)(ACT + (size_t)(u.rbase + pos) * DFF + f0) = w; } }
#endif
    }
};
struct EpiDown {
    static constexpr bool LB = true; static constexpr bool PERM = true; static constexpr int NS = 16; bf16_t* EO; const float* bdn; int dry; LAS const unsigned char* lb;
    __device__ __forceinline__ const float* bias_addr(const pg8::Unit& u, int idx) const { return bdn + (size_t)u.e * DM + u.pn * 256 + idx; }
    __device__ __forceinline__ void operator()(const f32x4 (&acc)[2][2][4][2], const pg8::Unit& u, int wr, int wc, int fr, int fq) const {
        if (dry & 1) return;
        const int col0 = u.pn * 256 + wc * 32 + 8 * fq; const LAS float* bl = (const LAS float*)(lb + u.slot * 1024) + wc * 32 + 8 * fq;
        f32x4 bv[2][2];
#pragma unroll
        for (int bj = 0; bj < 2; ++bj)
#pragma unroll
            for (int n = 0; n < 2; ++n) bv[bj][n] = *(const LAS f32x4*)(bl + bj * 128 + 4 * n);
#pragma unroll
        for (int ai = 0; ai < 2; ++ai)
#pragma unroll
            for (int m = 0; m < 4; ++m) { const int pos = u.pm * 256 + ai * 128 + wr * 64 + m * 16 + fr;
                {
#pragma unroll
                    for (int bj = 0; bj < 2; ++bj) { const f32x4 v0 = acc[ai][bj][m][0] + bv[bj][0], v1 = acc[ai][bj][m][1] + bv[bj][1];
#if EOUT_FP8
                        u32x2 w; w.x = pk4_fp8(v0[0], v0[1], v0[2], v0[3]); w.y = pk4_fp8(v1[0], v1[1], v1[2], v1[3]);
                        *(u32x2*)((unsigned char*)EO + (size_t)(u.rbase + pos) * DM + col0 + bj * 128) = w; }
#else
                        u32x4 w; w.x = pg8::cvt_pk_bf16(v0[0], v0[1]); w.y = pg8::cvt_pk_bf16(v0[2], v0[3]); w.z = pg8::cvt_pk_bf16(v1[0], v1[1]); w.w = pg8::cvt_pk_bf16(v1[2], v1[3]);
                        *(u32x4*)(EO + (size_t)(u.rbase + pos) * DM + col0 + bj * 128) = w; }
#endif
                } }
    }
};

template <int MODE, bool OUT8 = false>
__device__ __forceinline__ void tr_item(const float* W, int K, int N, const float* ksc, bf16_t* WT, LAS float* scr, int item, int lane, const float nsc = 1.0f) {
    const int nblk = N / 32, kb = item / nblk, nb = item % nblk, k0 = 64 * kb, n0 = 32 * nb;
    { const int n4 = (lane & 7) * 4; f32x4 v[8];
#pragma unroll
      for (int i = 0; i < 8; ++i) v[i] = *(const f32x4*)(W + (size_t)(k0 + 8 * i + (lane >> 3)) * N + n0 + n4);
#pragma unroll
      for (int i = 0; i < 8; ++i) { const int kk = 8 * i + (lane >> 3); const float sc = (ksc ? ksc[k0 + kk] : 1.0f) * nsc; LAS float* d = scr + kk * 33 + n4; d[0] = v[i][0] * sc; d[1] = v[i][1] * sc; d[2] = v[i][2] * sc; d[3] = v[i][3] * sc; } }
    LDS_WAIT(); asm volatile("" ::: "memory");
    const int c = lane & 7;
#pragma unroll
    for (int j = 0; j < 4; ++j) { const int n = (lane >> 3) + 8 * j; const LAS float* s = scr + (8 * c) * 33 + n;
        u32x4 o; o.x = pk2(s[0 * 33], s[1 * 33]); o.y = pk2(s[2 * 33], s[3 * 33]); o.z = pk2(s[4 * 33], s[5 * 33]); o.w = pk2(s[6 * 33], s[7 * 33]);
        int row = n0 + n; if (MODE == 1) { const int isup = row >> 10, f = row & 1023; row = (f >> 7) * 256 + isup * 128 + (f & 127); }
        if constexpr (OUT8) { u32x2 o8; o8.x = pk4_fp8(32.f * s[0 * 33], 32.f * s[1 * 33], 32.f * s[2 * 33], 32.f * s[3 * 33]); o8.y = pk4_fp8(32.f * s[4 * 33], 32.f * s[5 * 33], 32.f * s[6 * 33], 32.f * s[7 * 33]);
            *(u32x2*)((unsigned char*)WT + (size_t)row * K + k0 + 8 * c) = o8; }
        else *(u32x4*)(WT + (size_t)row * K + k0 + 8 * c) = o; }
    LDS_WAIT(); asm volatile("" ::: "memory");
}
template <int MODE>
__device__ __forceinline__ void tr_item8_load(f32x4 (&v)[16], float (&sc)[16], const float* W, int K, int N, const float* ksc, int item, int lane) {
    const int nblk = N / 32, kb = item / nblk, nb = item % nblk, k0 = 128 * kb, n0 = 32 * nb; const int n4 = (lane & 7) * 4; (void)K;
#pragma unroll
    for (int i = 0; i < 16; ++i) { v[i] = *(const f32x4*)(W + (size_t)(k0 + 8 * i + (lane >> 3)) * N + n0 + n4); sc[i] = ksc[k0 + 8 * i + (lane >> 3)]; }
}
template <int MODE>
__device__ __forceinline__ void tr_item8_store(const f32x4 (&v)[16], const float (&scv)[16], int K, int N, unsigned char* WT, LAS float* scr, int item, int lane) {
    const int nblk = N / 32, kb = item / nblk, nb = item % nblk, k0 = 128 * kb, n0 = 32 * nb; const int n4 = (lane & 7) * 4;
#pragma unroll
    for (int i = 0; i < 16; ++i) { const int kk = 8 * i + (lane >> 3); const float sc = 32.f * scv[i]; LAS float* d = scr + kk * 33 + n4; d[0] = v[i][0] * sc; d[1] = v[i][1] * sc; d[2] = v[i][2] * sc; d[3] = v[i][3] * sc; }
    LDS_WAIT(); asm volatile("" ::: "memory");
    const int c = lane & 7;
#pragma unroll
    for (int j = 0; j < 4; ++j) { const int n = (lane >> 3) + 8 * j; const LAS float* s = scr + (16 * c) * 33 + n;
        u32x4 o; o.x = pk4_fp8(s[0 * 33], s[1 * 33], s[2 * 33], s[3 * 33]); o.y = pk4_fp8(s[4 * 33], s[5 * 33], s[6 * 33], s[7 * 33]);
        o.z = pk4_fp8(s[8 * 33], s[9 * 33], s[10 * 33], s[11 * 33]); o.w = pk4_fp8(s[12 * 33], s[13 * 33], s[14 * 33], s[15 * 33]);
        int row = n0 + n; if (MODE == 1) { const int isup = row >> 10, f = row & 1023; row = (f >> 7) * 256 + isup * 128 + (f & 127); }
        *(u32x4*)(WT + (size_t)row * K + k0 + 16 * c) = o; }
    LDS_WAIT(); asm volatile("" ::: "memory");
}
template <int MODE>
__device__ __forceinline__ void tr_item8(const float* W, int K, int N, const float* ksc, unsigned char* WT, LAS float* scr, int item, int lane) {
    f32x4 v[16]; float sc[16]; tr_item8_load<MODE>(v, sc, W, K, N, ksc, item, lane); tr_item8_store<MODE>(v, sc, K, N, WT, scr, item, lane);
}
__device__ __forceinline__ void rms_row_to_bf16(const float* xrow, bf16_t* orow, int lane) {
    const f32x4* xr = (const f32x4*)xrow + lane;
    f32x4 v[4]; float s = 0.f;
#pragma unroll
    for (int j = 0; j < 4; ++j) { v[j] = xr[64 * j]; s += (v[j].x * v[j].x + v[j].y * v[j].y) + (v[j].z * v[j].z + v[j].w * v[j].w); }
    const float rs = 1.f / sqrtf(wave_sum(s) * (1.f / DM) + 1e-5f);
    unsigned long long* o8 = (unsigned long long*)orow + lane;
#pragma unroll
    for (int j = 0; j < 4; ++j) o8[64 * j] = (unsigned long long)pk2(v[j].x * rs, v[j].y * rs) | ((unsigned long long)pk2(v[j].z * rs, v[j].w * rs) << 32);
}
__device__ __forceinline__ void phase_prologue(const Args& a, LAS unsigned char* lds, int wave, int lane) {
    LAS float* scr = (LAS float*)(lds + wave * 8704);
    const int gw = blockIdx.x * NWAVES + wave, NGW = gridDim.x * NWAVES;
    bf16_t* Wt_in = (bf16_t*)(a.ws + WS_WIN); bf16_t* Wt_out = (bf16_t*)(a.ws + WS_WOUT);
    constexpr int I_IN = (DM / 64) * (INW / 32), I_OUT = (DM / 64) * (DM / 32);
    for (int it = gw; it < I_IN + I_OUT; it += NGW) {
        if (it < I_IN) { const int n0 = 32 * (it % (INW / 32));
            const float nsc = (n0 >= 3072 && n0 < 3136) ? 2.0f * 1.4426950408889634f : (n0 >= 3200 ? -1.4426950408889634f : 1.0f);
            tr_item<0>(a.in[I_WIN], DM, INW, a.in[I_GMIX], Wt_in, scr, it, lane, nsc); }
        else tr_item<0>(a.in[I_WOUT], DM, DM, nullptr, Wt_out, scr, it - I_IN, lane);
    }
    { bf16_t* wrt = (bf16_t*)(a.ws + WS_WRT); const float* wr = a.in[I_WR]; const float* gf = a.in[I_GFFN];
      for (int i = gw * 64 + lane; i < DM * 32; i += NGW * 64) { const int e = i & 31, k = i >> 5; const float v = wr[k * 32 + e] * gf[k];
          const unsigned hb = f2bf(v); const unsigned lb = f2bf(v - bf2f((unsigned short)hb)); bf16_t* d = wrt + (size_t)(k >> 9) * (2 * 32 * 520) + e * 520 + (k & 511); d[0] = (bf16_t)hb; d[32 * 520] = (bf16_t)lb; } }
    if (gw < 16) ((float*)(a.ws + WS_ONES))[gw * 64 + lane] = 1.0f;
    bf16_t* XN = (bf16_t*)(a.ws + WS_XN);
    for (int m = gw; m < MTOK; m += NGW) rms_row_to_bf16(a.in[I_X] + (size_t)m * DM, XN + (size_t)m * DM, lane);
}
__device__ __forceinline__ void expert_weight_items(const Args& a, LAS unsigned char* lds, int wave, int lane, int part, int nparts) {
    bf16_t* Wt_gu = (bf16_t*)(a.ws + WS_WGU); bf16_t* Wt_dn = (bf16_t*)(a.ws + WS_WDN);
#if MOE_FP8_GU && MOE_FP8_DN
    LAS float* scr = (LAS float*)(lds + wave * 16896);
    constexpr int I_GU = (DM / 128) * (2 * DFF / 32), I_DN = (DFF / 128) * (DM / 32);
    constexpr int NITEMS = NE * I_GU + NE * I_DN;
    unsigned* ctr = (unsigned*)(a.ws + WS_CTL) + CW_CONV; (void)part; (void)nparts;
    for (;;) {
        unsigned base = 0; if (lane == 0) base = atomicAdd(ctr, 4u); base = (unsigned)__builtin_amdgcn_readfirstlane((int)base);
        if (base >= (unsigned)NITEMS) break;
        const bool gu = base < (unsigned)(NE * I_GU); const int r0 = gu ? (int)base : (int)base - NE * I_GU, per = gu ? I_GU : I_DN, e = r0 / per, i0 = r0 % per;
        const float* W = gu ? a.in[I_WGUP] + (size_t)e * DM * 2 * DFF : a.in[I_WDN] + (size_t)e * DFF * DM;
        unsigned char* WT = gu ? (unsigned char*)Wt_gu + (size_t)e * 2 * DFF * DM : (unsigned char*)Wt_dn + (size_t)e * DM * DFF;
        const int N = gu ? 2 * DFF : DM; const float* ksc = gu ? a.in[I_GFFN] : (const float*)(a.ws + WS_ONES);
        f32x4 va[16], vb[16]; float sa[16], sb[16];
        tr_item8_load<0>(va, sa, W, DM, N, ksc, i0, lane);
#pragma unroll
        for (int q = 0; q < 4; q += 2) {
            tr_item8_load<0>(vb, sb, W, DM, N, ksc, i0 + q + 1, lane);
            if (gu) tr_item8_store<1>(va, sa, DM, N, WT, scr, i0 + q, lane); else tr_item8_store<0>(va, sa, DM, N, WT, scr, i0 + q, lane);
            if (q + 2 < 4) tr_item8_load<0>(va, sa, W, DM, N, ksc, i0 + q + 2, lane);
            if (gu) tr_item8_store<1>(vb, sb, DM, N, WT, scr, i0 + q + 1, lane); else tr_item8_store<0>(vb, sb, DM, N, WT, scr, i0 + q + 1, lane); }
    }
#else
    LAS float* scr = (LAS float*)(lds + wave * 8704);
    constexpr int I_GU = (DM / 64) * (2 * DFF / 32), I_DN = (DFF / 64) * (DM / 32);
    constexpr int NITEMS = NE * I_GU + NE * I_DN;
    for (int it = part * NWAVES + wave; it < NITEMS; it += nparts * NWAVES) {
        int r = it;
        if (r < NE * I_GU) { const int e = r / I_GU; tr_item<1, MOE_FP8_GU != 0>(a.in[I_WGUP] + (size_t)e * DM * 2 * DFF, DM, 2 * DFF, a.in[I_GFFN], (bf16_t*)((unsigned char*)Wt_gu + (size_t)e * 2 * DFF * DM * (MOE_FP8_GU ? 1 : 2)), scr, r % I_GU, lane); continue; } r -= NE * I_GU;
        { const int e = r / I_DN; tr_item<0, MOE_FP8_DN != 0>(a.in[I_WDN] + (size_t)e * DFF * DM, DFF, DM, nullptr, (bf16_t*)((unsigned char*)Wt_dn + (size_t)e * DM * DFF * (MOE_FP8_DN ? 1 : 2)), scr, r % I_DN, lane); }
    }
#endif
}

__device__ __forceinline__ int crow(int r, int hi) { return (r & 3) + 8 * (r >> 2) + 4 * hi; }
__device__ __forceinline__ s16x4 vtr(const LAS unsigned char* p) { typedef short v4i16_t __attribute__((ext_vector_type(4))); return __builtin_bit_cast(s16x4, __builtin_amdgcn_ds_read_tr16_b64_v4i16((LAS v4i16_t*)p)); }
constexpr int ATT_V_BYTES = 49152, ATT_WS_OFF = ATT_V_BYTES, ATT_OST_OFF = ATT_WS_OFF + NWAVES * 256;
__device__ __forceinline__ void attn_task(int T, const bf16_t* proj, bf16_t* opat, float* lse, LAS unsigned char* lds, int tid, const unsigned char* qkv8 = nullptr) {
    const int lane = tid & 63, wave = __builtin_amdgcn_readfirstlane(tid >> 6), r32 = lane & 31, hi = lane >> 5;
#ifdef PROBE_SLEEP_AT
    __builtin_amdgcn_s_sleep(50);
#endif
    const int b = T / 384, rem = T % 384, g = rem >> 7, h = (rem >> 4) & 7, sub = rem & 15;
    const int dl = (g == 0) ? 1 : (g == 1 ? 4 : 16);
    const int res = sub % dl, qb = sub / dl, u0 = qb * 256;
    const size_t rowb = (size_t)b * SEQ;
    int r32o = r32; asm volatile("" : "+v"(r32o));
    const int uq = u0 + 32 * wave + r32o; const size_t rowq = rowb + (size_t)uq * dl + res;
#if ATTN_QKV8
    long qf[4];
#pragma unroll
    for (int ds = 0; ds < 4; ++ds) qf[ds] = *(const long*)(qkv8 + rowq * 1536 + h * 64 + ds * 16 + hi * 8);
    u32x2 vst[6];
#pragma unroll
    for (int i = 0; i < 6; ++i) { const int c = tid + i * NTHR, ku = c >> 3, ch = c & 7; int uk = u0 - 128 + ku; uk = uk < 0 ? 0 : uk;
        vst[i] = *(const u32x2*)(qkv8 + (rowb + (size_t)uk * dl + res) * 1536 + 1024 + h * 64 + ch * 8); }
    f32x16 st[5];
#define ATT_KLOAD(dst, kt_) do { int rk = r32o; asm volatile("" : "+v"(rk)); int uk = u0 + 32 * wave - 128 + 32 * (kt_) + rk; if (uk < 0) uk = 0; \
        const unsigned char* kp = qkv8 + (rowb + (size_t)uk * dl + res) * 1536 + 512 + h * 64 + hi * 8; \
        _Pragma("unroll") for (int ds = 0; ds < 4; ++ds) dst[ds] = *(const long*)(kp + ds * 16); } while (0)
    const bf16x8 qbias = __builtin_bit_cast(bf16x8, (u32x4){hi ? 0u : (unsigned)f2bf((float)dl * exp2f((float)(2 - h))), 0u, 0u, 0u});
    { long kf[4], kn[4];
      ATT_KLOAD(kf, 0);
#pragma unroll
      for (int kt = 0; kt < 5; ++kt) {
          if (kt < 4) ATT_KLOAD(kn, kt + 1);
          f32x16 s = {};
#pragma unroll
          for (int ds = 0; ds < 4; ++ds) s = __builtin_amdgcn_mfma_f32_32x32x16_fp8_fp8(kf[ds], qf[ds], s, 0, 0, 0);
          { const unsigned kib = hi ? 0u : (unsigned)f2bf((float)(32 * kt + r32o));
            const bf16x8 ka = __builtin_bit_cast(bf16x8, (u32x4){kib, 0u, 0u, 0u});
            s = __builtin_amdgcn_mfma_f32_32x32x16_bf16(ka, qbias, s, 0, 0, 0); }
          st[kt] = s;
#pragma unroll
          for (int ds = 0; ds < 4; ++ds) kf[ds] = kn[ds]; } }
#undef ATT_KLOAD
#pragma unroll
    for (int i = 0; i < 6; ++i) { const int c = tid + i * NTHR, ku = c >> 3, ch = c & 7;
        const f32x2 a0 = __builtin_amdgcn_cvt_pk_f32_fp8((int)vst[i].x, false), a1 = __builtin_amdgcn_cvt_pk_f32_fp8((int)vst[i].x, true), a2 = __builtin_amdgcn_cvt_pk_f32_fp8((int)vst[i].y, false), a3 = __builtin_amdgcn_cvt_pk_f32_fp8((int)vst[i].y, true);
        u32x4 vw; vw.x = pk2(a0[0], a0[1]); vw.y = pk2(a1[0], a1[1]); vw.z = pk2(a2[0], a2[1]); vw.w = pk2(a3[0], a3[1]);
        *(LAS u32x4*)(lds + (ch >> 2) * 24576 + (ku >> 4) * 1024 + (ku & 15) * 64 + (ch & 3) * 16) = vw; }
#else
    bf16x8 qf[4];
#pragma unroll
    for (int ds = 0; ds < 4; ++ds) qf[ds] = *(const bf16x8*)(proj + rowq * INW + h * 64 + ds * 16 + hi * 8);
    u32x4 vst[6];
#pragma unroll
    for (int i = 0; i < 6; ++i) { const int c = tid + i * NTHR, ku = c >> 3, ch = c & 7; int uk = u0 - 128 + ku; uk = uk < 0 ? 0 : uk;
        vst[i] = *(const u32x4*)(proj + (rowb + (size_t)uk * dl + res) * INW + 1024 + h * 64 + ch * 8); }
    f32x16 st[5];
#define ATT_KLOAD(dst, kt_) do { int rk = r32o; asm volatile("" : "+v"(rk)); int uk = u0 + 32 * wave - 128 + 32 * (kt_) + rk; if (uk < 0) uk = 0; \
        const bf16_t* kp = proj + (rowb + (size_t)uk * dl + res) * INW + 512 + h * 64 + hi * 8; \
        _Pragma("unroll") for (int ds = 0; ds < 4; ++ds) dst[ds] = *(const bf16x8*)(kp + ds * 16); } while (0)
    { bf16x8 kf[4], kn[4];
      ATT_KLOAD(kf, 0);
#pragma unroll
      for (int kt = 0; kt < 5; ++kt) {
          if (kt < 4) ATT_KLOAD(kn, kt + 1);
          f32x16 s = {};
#pragma unroll
          for (int ds = 0; ds < 4; ++ds) s = __builtin_amdgcn_mfma_f32_32x32x16_bf16(kf[ds], qf[ds], s, 0, 0, 0);
          st[kt] = s;
#pragma unroll
          for (int ds = 0; ds < 4; ++ds) kf[ds] = kn[ds]; } }
#undef ATT_KLOAD
#pragma unroll
    for (int i = 0; i < 6; ++i) { const int c = tid + i * NTHR, ku = c >> 3, ch = c & 7;
        *(LAS u32x4*)(lds + (ch >> 2) * 24576 + (ku >> 4) * 1024 + (ku & 15) * 64 + (ch & 3) * 16) = vst[i]; }
#endif
#if ATTN_QKV8
    const float sl2 = exp2f(-(float)(h + 1)) * (float)dl * 1.4426950408889634f, scl = 0.18033688011112042f;
    const int dq = 128 + r32 - 4 * hi;
    int klo = 128 - u0 - 32 * wave - 4 * hi; if (dq - 128 > klo) klo = dq - 128;
    if (u0 == 0) {
#pragma unroll
        for (int kt = 1; kt < 4; ++kt)
#pragma unroll
            for (int r = 0; r < 16; ++r) { const int c = 32 * kt + (r & 3) + 8 * (r >> 2); st[kt][r] = (c >= klo) ? st[kt][r] : -INFINITY; } }
    float mx = -INFINITY;
#pragma unroll
    for (int kt = 0; kt < 5; ++kt)
#pragma unroll
        for (int r = 0; r < 16; ++r) { const int c = 32 * kt + (r & 3) + 8 * (r >> 2); float v = st[kt][r];
            if (kt == 0) { v = (c >= klo) ? v : -INFINITY; st[kt][r] = v; }
            if (kt == 4) { v = (c <= dq) ? v : -INFINITY; st[kt][r] = v; }
            mx = fmaxf(mx, v); }
    mx = fmaxf(mx, __shfl_xor(mx, 32));
    const float nmxs = -mx * scl;
    float lsum = 0.f;
#pragma unroll
    for (int kt = 0; kt < 5; ++kt)
#pragma unroll
        for (int r = 0; r < 16; ++r) { float df; asm("v_fma_f32 %0, %1, %2, %3" : "=v"(df) : "v"(st[kt][r]), "v"(scl), "v"(nmxs)); const float p = __builtin_amdgcn_exp2f(df); st[kt][r] = p; lsum += p; }
    lsum += __shfl_xor(lsum, 32);
    mx = -nmxs - sl2 * (float)(128 + r32);
#else
    const float sl2 = exp2f(-(float)(h + 1)) * (float)dl * 1.4426950408889634f;
    const int dq = 128 + r32 - 4 * hi;
    int klo = 128 - u0 - 32 * wave - 4 * hi; if (dq - 128 > klo) klo = dq - 128;
    const float nb = -sl2 * (float)dq;
    float mx = -INFINITY;
#pragma unroll
    for (int kt = 0; kt < 5; ++kt)
#pragma unroll
        for (int r = 0; r < 16; ++r) { const int c = 32 * kt + (r & 3) + 8 * (r >> 2);
            float bias, sc; asm("v_fma_f32 %0, %1, %2, %3" : "=v"(bias) : "v"(sl2), "v"((float)c), "v"(nb));
            asm("v_fma_f32 %0, %1, %2, %3" : "=v"(sc) : "v"(st[kt][r]), "v"(0.18033688011112042f), "v"(bias));
            const bool ok = (c <= dq) && (c >= klo);
            sc = ok ? sc : -INFINITY; st[kt][r] = sc; mx = fmaxf(mx, sc); }
    mx = fmaxf(mx, __shfl_xor(mx, 32));
    float lsum = 0.f;
#pragma unroll
    for (int kt = 0; kt < 5; ++kt)
#pragma unroll
        for (int r = 0; r < 16; ++r) { float df; asm("v_sub_f32 %0, %1, %2" : "=v"(df) : "v"(st[kt][r]), "v"(mx)); const float p = __builtin_amdgcn_exp2f(df); st[kt][r] = p; lsum += p; }
    lsum += __shfl_xor(lsum, 32);
#endif
    __syncthreads();
    f32x16 o[2]; o[0] = f32x16{}; o[1] = f32x16{};
    const LAS unsigned char* vb = lds + ((lane >> 4) & 1) * 32 + (lane & 3) * 8 + (4 * hi + ((lane & 15) >> 2)) * 64;
#pragma unroll
    for (int kt = 0; kt < 5; ++kt)
#pragma unroll
        for (int s2 = 0; s2 < 2; ++s2) { const int kg = 2 * wave + 2 * kt + s2;
            u32x4 pw; pw.x = pk2(st[kt][8 * s2 + 0], st[kt][8 * s2 + 1]); pw.y = pk2(st[kt][8 * s2 + 2], st[kt][8 * s2 + 3]); pw.z = pk2(st[kt][8 * s2 + 4], st[kt][8 * s2 + 5]); pw.w = pk2(st[kt][8 * s2 + 6], st[kt][8 * s2 + 7]);
            const bf16x8 pa = __builtin_bit_cast(bf16x8, pw);
#pragma unroll
            for (int d0 = 0; d0 < 2; ++d0) { const LAS unsigned char* p = vb + d0 * 24576 + kg * 1024; const s16x4 lo = vtr(p), hh = vtr(p + 512);
                const bf16x8 vf = (bf16x8){lo[0], lo[1], lo[2], lo[3], hh[0], hh[1], hh[2], hh[3]};
                o[d0] = __builtin_amdgcn_mfma_f32_32x32x16_bf16(pa, vf, o[d0], 0, 0, 0); } asm volatile("" ::: "memory"); }
    LAS float* wsf = (LAS float*)(lds + ATT_WS_OFF) + wave * 64;
    if (hi == 0) wsf[r32] = __builtin_amdgcn_rcpf(lsum);
    LDS_WAIT();
    LAS bf16_t* stg = (LAS bf16_t*)(lds + ATT_OST_OFF) + wave * 2048;
#pragma unroll
    for (int r = 0; r < 16; ++r) { const int orow = crow(r, hi); const float li = wsf[orow];
#pragma unroll
        for (int d0 = 0; d0 < 2; ++d0) stg[orow * 64 + d0 * 32 + r32] = (bf16_t)f2bf(o[d0][r] * li); }
    LDS_WAIT();
    bf16_t* og = opat + (size_t)g * MTOK * 512;
#pragma unroll
    for (int i = 0; i < 4; ++i) { const int row = i * 8 + (lane >> 3), ch = lane & 7; const u32x4 v = *(const LAS u32x4*)(stg + row * 64 + ch * 8);
        const size_t tok = rowb + (size_t)(u0 + 32 * wave + row) * dl + res; *(u32x4*)(og + tok * 512 + h * 64 + ch * 8) = v; }
    if (hi == 0) lse[((size_t)g * MTOK + rowq) * NH + h] = (mx + __log2f(lsum)) * 0.6931471805599453f;
    __syncthreads();
}

#if ATTN_QKV8
__device__ __forceinline__ void attn_loop(int T0, int Tstep, int Tend, const unsigned char* qkv8, bf16_t* opat, float* lse, LAS unsigned char* lds, int tid, const unsigned pm = 0u) {
    const int lane = tid & 63, wave = __builtin_amdgcn_readfirstlane(tid >> 6), r32 = lane & 31, hi = lane >> 5;
    if (T0 >= Tend) return;
#define ATT_BAR() do { asm volatile("s_waitcnt lgkmcnt(0)" ::: "memory"); __builtin_amdgcn_s_barrier(); asm volatile("" ::: "memory"); } while (0)
    constexpr int ATT_KIMG = ATT_OST_OFF + NWAVES * 4096;
    u32x4 kst[3], vst[3], qst[2];
#define ATT_DECODE(T_) const int b = (T_) / 384, rem = (T_) % 384, g = rem >> 7, h = (rem >> 4) & 7, sub = rem & 15; const int dl = (g == 0) ? 1 : (g == 1 ? 4 : 16); \
        const int res = sub % dl, u0 = (sub / dl) * 256; const size_t rowb = (size_t)b * SEQ;
#define ATT_ISSUE_KV(T_) do { ATT_DECODE(T_); _Pragma("unroll") for (int i = 0; i < 3; ++i) { int tv = tid; asm volatile("" : "+v"(tv)); const int p = tv + i * NTHR, ku = p >> 2, q4 = p & 3; int uk = u0 - 128 + ku; uk = uk < 0 ? 0 : uk; \
            const unsigned char* rp = qkv8 + (rowb + (size_t)uk * dl + res) * 1536 + h * 64 + q4 * 16; kst[i] = *(const u32x4*)(rp + 512); vst[i] = *(const u32x4*)(rp + 1024); } } while (0)
#define ATT_ISSUE_Q(T_) do { ATT_DECODE(T_); int rk = r32; asm volatile("" : "+v"(rk)); const size_t rowq_ = rowb + (size_t)(u0 + 32 * wave + rk) * dl + res; \
        _Pragma("unroll") for (int dp = 0; dp < 2; ++dp) qst[dp] = *(const u32x4*)(qkv8 + rowq_ * 1536 + h * 64 + dp * 32 + hi * 16); } while (0)
#define ATT_PIN() do { _Pragma("unroll") for (int i = 0; i < 3; ++i) { asm volatile("" : "+v"(kst[i])); asm volatile("" : "+v"(vst[i])); } asm volatile("" : "+v"(qst[0])); asm volatile("" : "+v"(qst[1])); } while (0)
    ATT_ISSUE_KV(T0); ATT_ISSUE_Q(T0);
    ATT_PIN();
#pragma unroll 1
    for (int T = T0; T < Tend; T += Tstep) {
        ATT_DECODE(T);
        int r32o = r32; asm volatile("" : "+v"(r32o));
        const size_t rowq = rowb + (size_t)(u0 + 32 * wave + r32o) * dl + res;
#pragma unroll
        for (int i = 0; i < 3; ++i) { const int p = tid + i * NTHR, ku = p >> 2, q4 = p & 3;
            LAS unsigned char* kd = lds + ATT_KIMG + ku * 72 + q4 * 16; *(LAS u32x2*)kd = (u32x2){kst[i].x, kst[i].y}; *(LAS u32x2*)(kd + 8) = (u32x2){kst[i].z, kst[i].w};
#pragma unroll
            for (int hf = 0; hf < 2; ++hf) { const int ch = 2 * q4 + hf; const unsigned w0 = hf ? vst[i].z : vst[i].x, w1 = hf ? vst[i].w : vst[i].y;
                const f32x2 a0 = __builtin_amdgcn_cvt_pk_f32_fp8((int)w0, false), a1 = __builtin_amdgcn_cvt_pk_f32_fp8((int)w0, true), a2 = __builtin_amdgcn_cvt_pk_f32_fp8((int)w1, false), a3 = __builtin_amdgcn_cvt_pk_f32_fp8((int)w1, true);
                u32x4 vw; vw.x = pk2(a0[0], a0[1]); vw.y = pk2(a1[0], a1[1]); vw.z = pk2(a2[0], a2[1]); vw.w = pk2(a3[0], a3[1]);
                *(LAS u32x4*)(lds + (ch >> 2) * 24576 + (ku >> 4) * 1024 + (ku & 15) * 64 + (ch & 3) * 16) = vw; } }
        ATT_BAR();
        if (!(pm & 1u)) { const int Tn = (T + Tstep < Tend) ? T + Tstep : T; ATT_ISSUE_KV(Tn); }
        f32x16 st[5];
        { const bf16x8 qbias = __builtin_bit_cast(bf16x8, (u32x4){hi ? 0u : (unsigned)f2bf((float)dl * exp2f((float)(2 - h))), 0u, 0u, 0u});
          long qf[4]; qf[0] = (long)(((unsigned long)qst[0].y << 32) | qst[0].x); qf[1] = (long)(((unsigned long)qst[0].w << 32) | qst[0].z); qf[2] = (long)(((unsigned long)qst[1].y << 32) | qst[1].x); qf[3] = (long)(((unsigned long)qst[1].w << 32) | qst[1].z);
          const LAS unsigned char* kb = lds + ATT_KIMG + (32 * wave + r32o) * 72 + 16 * hi;
#pragma unroll
          for (int kt = 0; kt < 5; ++kt) { f32x16 sx = {}; long kf[4];
#pragma unroll
              for (int ds = 0; ds < 4; ++ds) kf[ds] = *(const LAS long*)(kb + kt * 32 * 72 + 32 * (ds >> 1) + 8 * (ds & 1));
#pragma unroll
              for (int ds = 0; ds < 4; ++ds) sx = __builtin_amdgcn_mfma_f32_32x32x16_fp8_fp8(kf[ds], qf[ds], sx, 0, 0, 0);
              const unsigned kib = hi ? 0u : (unsigned)f2bf((float)(32 * kt + r32o));
              sx = __builtin_amdgcn_mfma_f32_32x32x16_bf16(__builtin_bit_cast(bf16x8, (u32x4){kib, 0u, 0u, 0u}), qbias, sx, 0, 0, 0);
              st[kt] = sx; } }
        if (!(pm & 1u)) { const int Tn = (T + Tstep < Tend) ? T + Tstep : T; ATT_ISSUE_Q(Tn); }
        const float sl2 = exp2f(-(float)(h + 1)) * (float)dl * 1.4426950408889634f, scl = 0.18033688011112042f;
        const int dq = 128 + r32 - 4 * hi;
        int klo = 128 - u0 - 32 * wave - 4 * hi; if (dq - 128 > klo) klo = dq - 128;
        if (u0 == 0) {
#pragma unroll
            for (int kt = 1; kt < 4; ++kt)
#pragma unroll
                for (int r = 0; r < 16; ++r) { const int c = 32 * kt + (r & 3) + 8 * (r >> 2); st[kt][r] = (c >= klo) ? st[kt][r] : -INFINITY; } }
        float mx = -INFINITY, lsum = 0.f;
        if (!(pm & 2u)) {
#pragma unroll
        for (int kt = 0; kt < 5; ++kt)
#pragma unroll
            for (int r = 0; r < 16; ++r) { const int c = 32 * kt + (r & 3) + 8 * (r >> 2); float v = st[kt][r];
                if (kt == 0) { v = (c >= klo) ? v : -INFINITY; st[kt][r] = v; }
                if (kt == 4) { v = (c <= dq) ? v : -INFINITY; st[kt][r] = v; }
                mx = fmaxf(mx, v); }
        mx = fmaxf(mx, __shfl_xor(mx, 32));
        const float nmxs = -mx * scl;
#pragma unroll
        for (int kt = 0; kt < 5; ++kt)
#pragma unroll
            for (int r = 0; r < 16; ++r) { float df; asm("v_fma_f32 %0, %1, %2, %3" : "=v"(df) : "v"(st[kt][r]), "v"(scl), "v"(nmxs)); const float p = __builtin_amdgcn_exp2f(df); st[kt][r] = p; lsum += p; }
        lsum += __shfl_xor(lsum, 32);
        mx = -nmxs - sl2 * (float)(128 + r32); }
        f32x16 o[2]; o[0] = f32x16{}; o[1] = f32x16{};
        const LAS unsigned char* vb = lds + ((lane >> 4) & 1) * 32 + (lane & 3) * 8 + (4 * hi + ((lane & 15) >> 2)) * 64 + 2 * wave * 1024;
        s16x4 vlo[2][2], vhh[2][2];
#pragma unroll
        for (int d0 = 0; d0 < 2; ++d0) { vlo[0][d0] = vtr(vb + d0 * 24576); vhh[0][d0] = vtr(vb + d0 * 24576 + 512); }
        if (!(pm & 4u))
#pragma unroll
        for (int sp = 0; sp < 10; ++sp) { const int cb = sp & 1, kt = sp >> 1, s2 = sp & 1;
            if (sp < 9) {
#pragma unroll
                for (int d0 = 0; d0 < 2; ++d0) { const LAS unsigned char* p = vb + d0 * 24576 + (sp + 1) * 1024; vlo[cb ^ 1][d0] = vtr(p); vhh[cb ^ 1][d0] = vtr(p + 512); } }
            u32x4 pw; pw.x = pk2(st[kt][8 * s2 + 0], st[kt][8 * s2 + 1]); pw.y = pk2(st[kt][8 * s2 + 2], st[kt][8 * s2 + 3]); pw.z = pk2(st[kt][8 * s2 + 4], st[kt][8 * s2 + 5]); pw.w = pk2(st[kt][8 * s2 + 6], st[kt][8 * s2 + 7]);
            const bf16x8 pa = __builtin_bit_cast(bf16x8, pw);
#pragma unroll
            for (int d0 = 0; d0 < 2; ++d0) { const s16x4 lo = vlo[cb][d0], hh = vhh[cb][d0];
                const bf16x8 vf = (bf16x8){lo[0], lo[1], lo[2], lo[3], hh[0], hh[1], hh[2], hh[3]};
                o[d0] = __builtin_amdgcn_mfma_f32_32x32x16_bf16(pa, vf, o[d0], 0, 0, 0); }
            asm volatile("" ::: "memory"); }
        const float rl = __builtin_amdgcn_rcpf(lsum);
        LAS bf16_t* stg = (LAS bf16_t*)(lds + ATT_OST_OFF) + wave * 2048;
        if (!(pm & 8u))
#pragma unroll
        for (int r = 0; r < 16; ++r) { const int orow = crow(r, hi);
            const float l0 = __builtin_bit_cast(float, __builtin_amdgcn_readlane(__builtin_bit_cast(int, rl), crow(r, 0))), l1 = __builtin_bit_cast(float, __builtin_amdgcn_readlane(__builtin_bit_cast(int, rl), crow(r, 1)));
            const float li = hi ? l1 : l0;
#pragma unroll
            for (int d0 = 0; d0 < 2; ++d0) stg[orow * 64 + d0 * 32 + r32] = (bf16_t)f2bf(o[d0][r] * li); }
        LDS_WAIT();
        ATT_PIN();
        bf16_t* og = opat + (size_t)g * MTOK * 512;
#pragma unroll
        for (int i = 0; i < 4; ++i) { const int row = i * 8 + (lane >> 3), ch = lane & 7; const u32x4 v = *(const LAS u32x4*)(stg + row * 64 + ch * 8);
            const size_t tok = rowb + (size_t)(u0 + 32 * wave + row) * dl + res; if (!(pm & 0x80000000u)) *(u32x4*)(og + tok * 512 + h * 64 + ch * 8) = v; else if (v.x == 0x12345679u) og[0] = 0; }
        if (hi == 0 && !(pm & 0x80000000u)) lse[((size_t)g * MTOK + rowq) * NH + h] = (mx + __log2f(lsum)) * 0.6931471805599453f;
        ATT_BAR();
    }
#undef ATT_BAR
#undef ATT_PIN
#undef ATT_ISSUE_KV
#undef ATT_ISSUE_Q
#undef ATT_DECODE
}
#endif
constexpr int RT = 32;
__device__ __forceinline__ void rwkv_head(int b, int h, const Args& a, const bf16_t* proj, bf16_t* mix, LAS unsigned char* lds, int tid) {
    const int lane = tid & 63, wave = __builtin_amdgcn_readfirstlane(tid >> 6);
    LAS float* R_ = (LAS float*)lds;
    LAS float* KX = R_ + RT * 64; LAS float* V_ = KX + RT * 64; LAS float* WD = V_ + RT * 64; LAS float* AD = WD + RT * 64;
    LAS float* GD = AD + RT * 64;
    LAS float* DEC = GD + RT * 128; LAS float* KK = DEC + RT * 64; LAS float* BB = KK + RT * 64; LAS float* G_ = BB + RT * 64; LAS float* Y_ = G_ + RT * 64;
    const float* mu = a.in[I_MU];
    const int hc = h * 64 + lane;
    const float w0 = a.in[I_W0][hc], a0 = a.in[I_A0][hc], kkw = a.in[I_KK][hc], kaw = a.in[I_KA][hc], rkw = a.in[I_RK][hc], gnw = a.in[I_GNW][hc], gnb = a.in[I_GNB][hc];
    LAS bf16_t* WL = (LAS bf16_t*)(Y_ + RT * 64);
    __syncthreads();
    for (int i = tid; i < 256 * 64; i += NTHR) { const int l = i >> 6, c = i & 63; const float w = (l < 64) ? a.in[I_WDU][l * 512 + h * 64 + c] : (l < 128 ? a.in[I_WIU][(l - 64) * 512 + h * 64 + c] : a.in[I_WGU][(l - 128) * 512 + h * 64 + c]); WL[i] = (bf16_t)f2bf(w); }
    float Sx[8];
#pragma unroll
    for (int x = 0; x < 8; ++x) Sx[x] = 0.f;
    const int si = 8 * wave + (lane >> 3), jo = lane & 7;
    const size_t rowb = (size_t)b * SEQ;
    for (int blk = 0; blk < SEQ / RT; ++blk) {
        const int t0 = blk * RT;
        for (int it = tid; it < RT * 56; it += NTHR) { const int tt = it / 56, cc = it % 56;
            int col; LAS float* dst; int mode = 0;
            if (cc < 8) { col = 1536 + h * 64 + cc * 8; dst = R_ + tt * 64 + cc * 8; }
            else if (cc < 16) { col = 2048 + h * 64 + (cc - 8) * 8; dst = KX + tt * 64 + (cc - 8) * 8; }
            else if (cc < 24) { col = 2560 + h * 64 + (cc - 16) * 8; dst = V_ + tt * 64 + (cc - 16) * 8; }
            else if (cc < 32) { col = 3072 + (cc - 24) * 8; dst = WD + tt * 64 + (cc - 24) * 8; mode = 1; }
            else if (cc < 40) { col = 3136 + (cc - 32) * 8; dst = AD + tt * 64 + (cc - 32) * 8; }
            else { col = 3200 + (cc - 40) * 8; dst = GD + tt * 128 + (cc - 40) * 8; mode = 2; }
            const bf16_t* p = proj + (rowb + t0 + tt) * INW + col;
            const u32x4 cu = *(const u32x4*)p; u32x4 pv = (u32x4){0u, 0u, 0u, 0u}; if (t0 + tt > 0) pv = *(const u32x4*)(p - INW);
            const f32x4 m0 = *(const f32x4*)(mu + col - 1536), m1 = *(const f32x4*)(mu + col - 1536 + 4);
            float o[8];
#pragma unroll
            for (int q = 0; q < 4; ++q) { const float c0 = bflo(cu[q]), c1 = bfhi(cu[q]), p0 = bflo(pv[q]), p1 = bfhi(pv[q]); const float ma = (q < 2) ? m0[2 * q] : m1[2 * q - 4], mb = (q < 2) ? m0[2 * q + 1] : m1[2 * q - 3];
                o[2 * q] = c0 + (p0 - c0) * ma; o[2 * q + 1] = c1 + (p1 - c1) * mb; }
#pragma unroll
            for (int q = 0; q < 8; ++q) { float v = o[q]; if (mode == 1) v = tanhf(v); else if (mode == 2) v = sigmoidf_(v); dst[q] = v; }
        }
        __syncthreads();
        {
            float wp[4], ap[4], gp[4];
#pragma unroll
            for (int i = 0; i < 4; ++i) { wp[i] = w0; ap[i] = a0; gp[i] = 0.f; }
#pragma unroll 2
            for (int l = 0; l < 64; l += 4) {
                float wd[4], wi[4];
#pragma unroll
                for (int q = 0; q < 4; ++q) { wd[q] = bf2f(WL[(l + q) * 64 + lane]); wi[q] = bf2f(WL[(64 + l + q) * 64 + lane]); }
#pragma unroll
                for (int i = 0; i < 4; ++i) { const f32x4 xw = *(const LAS f32x4*)(WD + (4 * wave + i) * 64 + l), xa = *(const LAS f32x4*)(AD + (4 * wave + i) * 64 + l);
                    wp[i] += xw[0] * wd[0] + xw[1] * wd[1] + xw[2] * wd[2] + xw[3] * wd[3]; ap[i] += xa[0] * wi[0] + xa[1] * wi[1] + xa[2] * wi[2] + xa[3] * wi[3]; } }
#pragma unroll 2
            for (int l = 0; l < 128; l += 4) {
                float wg[4];
#pragma unroll
                for (int q = 0; q < 4; ++q) wg[q] = bf2f(WL[(128 + l + q) * 64 + lane]);
#pragma unroll
                for (int i = 0; i < 4; ++i) { const f32x4 xg = *(const LAS f32x4*)(GD + (4 * wave + i) * 128 + l); gp[i] += xg[0] * wg[0] + xg[1] * wg[1] + xg[2] * wg[2] + xg[3] * wg[3]; } }
#pragma unroll
            for (int i = 0; i < 4; ++i) { const int tt = 4 * wave + i;
                const float z = -wp[i]; const float sp = fmaxf(z, 0.f) + log1pf(__expf(-fabsf(z)));
                const float w = -sp - 0.5f; const float dec = __expf(-__expf(w));
                const float av = sigmoidf_(ap[i]);
                const float kx = KX[tt * 64 + lane]; const float kr = kx * kkw; const float n2 = wave_sum(kr * kr);
                const float kk = kr / fmaxf(sqrtf(n2), 1e-12f);
                DEC[tt * 64 + lane] = dec; KK[tt * 64 + lane] = kk; BB[tt * 64 + lane] = kk * av; KX[tt * 64 + lane] = kx * (1.0f + (av - 1.0f) * kaw); G_[tt * 64 + lane] = gp[i]; }
        }
        __syncthreads();
#pragma unroll 2
        for (int s = 0; s < RT; ++s) {
            const f32x4 k0 = *(const LAS f32x4*)(KK + s * 64 + 8 * jo), k1 = *(const LAS f32x4*)(KK + s * 64 + 8 * jo + 4);
            float sa = Sx[0] * k0[0] + Sx[1] * k0[1] + Sx[2] * k0[2] + Sx[3] * k0[3] + Sx[4] * k1[0] + Sx[5] * k1[1] + Sx[6] * k1[2] + Sx[7] * k1[3];
            sa = sum8(sa);
            const f32x4 d0 = *(const LAS f32x4*)(DEC + s * 64 + 8 * jo), d1 = *(const LAS f32x4*)(DEC + s * 64 + 8 * jo + 4);
            const f32x4 b0 = *(const LAS f32x4*)(BB + s * 64 + 8 * jo), b1 = *(const LAS f32x4*)(BB + s * 64 + 8 * jo + 4);
            const f32x4 x0 = *(const LAS f32x4*)(KX + s * 64 + 8 * jo), x1 = *(const LAS f32x4*)(KX + s * 64 + 8 * jo + 4);
            const f32x4 r0 = *(const LAS f32x4*)(R_ + s * 64 + 8 * jo), r1 = *(const LAS f32x4*)(R_ + s * 64 + 8 * jo + 4);
            const float vi = V_[s * 64 + si];
            float y = 0.f;
#pragma unroll
            for (int x = 0; x < 4; ++x) { Sx[x] = Sx[x] * d0[x] - sa * b0[x] + vi * x0[x]; y += Sx[x] * r0[x]; Sx[4 + x] = Sx[4 + x] * d1[x] - sa * b1[x] + vi * x1[x]; y += Sx[4 + x] * r1[x]; }
            y = sum8(y);
            if (jo == 0) Y_[s * 64 + si] = y;
        }
        __syncthreads();
#pragma unroll
        for (int i = 0; i < 4; ++i) { const int tt = 4 * wave + i;
            const float y = Y_[tt * 64 + lane]; const float mean = wave_sum(y) * (1.f / 64.f); const float dv = y - mean; const float var = wave_sum(dv * dv) * (1.f / 64.f);
            const float yn = dv * (1.0f / sqrtf(var + 64e-5f)) * gnw + gnb;
            const float bs = wave_sum(R_[tt * 64 + lane] * KX[tt * 64 + lane] * rkw);
            const float ov = (yn + bs * V_[tt * 64 + lane]) * G_[tt * 64 + lane];
            mix[(rowb + t0 + tt) * DM + 512 + hc] = (bf16_t)f2bf(ov); }
        __syncthreads();
    }
}

namespace rk {
constexpr int SLOT = 8192, LDF = 68;
constexpr int O_F0 = 16 * SLOT, O_NP = O_F0 + 64 * LDF * 4, O_BP = O_NP + 2048, O_GAM = O_BP + 2048, O_CST = O_GAM + 256, O_PS = O_CST + 5 * 64 * 4, LDP = 36, O_END = O_PS + 64 * LDP * 4;
__device__ __forceinline__ int AD(int r, int c) { return (r << 6) + ((((c >> 3) ^ r) & 7) << 3) + (c & 7); }
__device__ __forceinline__ int AD2(int r, int c) { return (r << 7) + ((((c >> 3) ^ r) & 15) << 3) + (c & 7); }
__device__ __forceinline__ void mm(const LAS bf16_t* Bs, const LAS bf16_t* As, int qb, int pb0, int fr, int kq, f32x4 (&acc)[2]) {
#pragma unroll
    for (int ks = 0; ks < 2; ++ks) { const bf16x8 a = *(const LAS bf16x8*)(As + AD(16 * qb + fr, 32 * ks + 8 * kq));
#pragma unroll
        for (int c = 0; c < 2; ++c) { const bf16x8 b = *(const LAS bf16x8*)(Bs + AD(16 * (pb0 + c) + fr, 32 * ks + 8 * kq)); acc[c] = __builtin_amdgcn_mfma_f32_16x16x32_bf16(a, b, acc[c], 0, 0, 0); } }
}
struct Frag { bf16x8 a[2]; bf16x8 b[2][2]; };
__device__ __forceinline__ void ldf(Frag& f, const LAS bf16_t* Bs, const LAS bf16_t* As, int qb, int pb0, int fr, int kq) {
#pragma unroll
    for (int ks = 0; ks < 2; ++ks) { f.a[ks] = *(const LAS bf16x8*)(As + AD(16 * qb + fr, 32 * ks + 8 * kq));
#pragma unroll
        for (int c = 0; c < 2; ++c) f.b[c][ks] = *(const LAS bf16x8*)(Bs + AD(16 * (pb0 + c) + fr, 32 * ks + 8 * kq)); }
}
__device__ __forceinline__ void mmf(const Frag& f, f32x4 (&acc)[2]) {
#pragma unroll
    for (int ks = 0; ks < 2; ++ks)
#pragma unroll
        for (int c = 0; c < 2; ++c) acc[c] = __builtin_amdgcn_mfma_f32_16x16x32_bf16(f.a[ks], f.b[c][ks], acc[c], 0, 0, 0);
}
__device__ __forceinline__ void mmt(const Frag& f, f32x4 (&acc)[2]) {
#pragma unroll
    for (int ks = 0; ks < 2; ++ks)
#pragma unroll
        for (int c = 0; c < 2; ++c) acc[c] = __builtin_amdgcn_mfma_f32_16x16x32_bf16(f.b[c][ks], f.a[ks], acc[c], 0, 0, 0);
}
#define RK_LOADED() do { __builtin_amdgcn_sched_barrier(0); } while (0)
__device__ __forceinline__ void st4(LAS bf16_t* O, int p, int q0, const f32x4 v) { u32x2 w; w.x = pk2(v[0], v[1]); w.y = pk2(v[2], v[3]); *(LAS u32x2*)(O + AD(p, q0)) = w; }
__device__ __forceinline__ f32x4 ld4(const LAS bf16_t* O, int p, int q0) { const u32x2 w = *(const LAS u32x2*)(O + AD(p, q0)); return (f32x4){bflo(w.x), bfhi(w.x), bflo(w.y), bfhi(w.y)}; }
__device__ __forceinline__ float ex2(float x) { return __builtin_amdgcn_exp2f(x); }
#define RK_ZERO(a) do { a[0] = (f32x4){0.f, 0.f, 0.f, 0.f}; a[1] = (f32x4){0.f, 0.f, 0.f, 0.f}; } while (0)
#define RK_BAR() do { asm volatile("s_waitcnt lgkmcnt(0)" ::: "memory"); __builtin_amdgcn_s_barrier(); asm volatile("" ::: "memory"); } while (0)
}
__device__ __forceinline__ void phase_lora_pre(const Args& a, const bf16_t* proj, bf16_t* lora, int tid) {
    using namespace rk;
    const float* mu = a.in[I_MU];
    const int chn = tid & 31, col = 3072 + 8 * chn;
    const f32x4 m0 = *(const f32x4*)(mu + col - 1536), m1 = *(const f32x4*)(mu + col - 1536 + 4);
    u32x4 cu[4], pv[4];
    const int blk0 = blockIdx.x;
#define LP_LOAD(blk_) do { const int b_ = (blk_) >> 6, c_ = (blk_) & 63; _Pragma("unroll") for (int i = 0; i < 4; ++i) { const int t_ = (tid + i * NTHR) >> 5; const size_t row_ = (size_t)b_ * SEQ + 64 * c_ + t_; \
        cu[i] = *(const u32x4*)(proj + row_ * INW + col); pv[i] = *(const u32x4*)(proj + (row_ - ((64 * c_ + t_ > 0) ? 1 : 0)) * INW + col); } } while (0)
    if (blk0 < NB * (SEQ / 64)) LP_LOAD(blk0);
    for (int blk = blk0; blk < NB * (SEQ / 64); blk += gridDim.x) {
        const int c = blk & 63; bf16_t* dst = lora + (size_t)blk * 16384;
        u32x4 ccu[4], cpv[4];
#pragma unroll
        for (int i = 0; i < 4; ++i) { ccu[i] = cu[i]; cpv[i] = pv[i]; }
        asm volatile("" : "+v"(ccu[0]), "+v"(ccu[1]), "+v"(ccu[2]), "+v"(ccu[3]), "+v"(cpv[0]), "+v"(cpv[1]), "+v"(cpv[2]), "+v"(cpv[3]));
        if (blk + (int)gridDim.x < NB * (SEQ / 64)) LP_LOAD(blk + (int)gridDim.x);
#pragma unroll
        for (int i = 0; i < 4; ++i) { const int t = (tid + i * NTHR) >> 5;
            u32x4 pvv = cpv[i]; if (64 * c + t == 0) pvv = (u32x4){0u, 0u, 0u, 0u};
            const u32x4 cuv = ccu[i];
            float o[8];
#pragma unroll
            for (int x = 0; x < 4; ++x) { const float c0 = bflo(cuv[x]), c1 = bfhi(cuv[x]), p0 = bflo(pvv[x]), p1 = bfhi(pvv[x]), ma = (x < 2) ? m0[2 * x] : m1[2 * x - 4], mb = (x < 2) ? m0[2 * x + 1] : m1[2 * x - 3];
                o[2 * x] = c0 + (p0 - c0) * ma; o[2 * x + 1] = c1 + (p1 - c1) * mb; }
            if (chn < 8) {
#pragma unroll
                for (int x = 0; x < 8; ++x) o[x] = 1.0f - 2.0f * __builtin_amdgcn_rcpf(1.0f + ex2(o[x]));
            } else if (chn >= 16) {
#pragma unroll
                for (int x = 0; x < 8; ++x) o[x] = __builtin_amdgcn_rcpf(1.0f + ex2(o[x]));
            }
            u32x4 w; w.x = pk2(o[0], o[1]); w.y = pk2(o[2], o[3]); w.z = pk2(o[4], o[5]); w.w = pk2(o[6], o[7]);
            const int off = (chn < 8) ? AD(t, 8 * chn) : (chn < 16) ? 4096 + AD(t, 8 * (chn - 8)) : 8192 + AD2(t, 8 * (chn - 16));
            *(u32x4*)(dst + off) = w; }
    }
#undef LP_LOAD
}
__device__ __forceinline__ void rwkv_head_chunked(int b, int h, const Args& a, const bf16_t* proj, bf16_t* mix, LAS unsigned char* lds, int tid, const unsigned skip = 0u, const bf16_t* lora = nullptr, unsigned* prog = nullptr) {
    using namespace rk;
    const int lane0 = tid & 63, wave = __builtin_amdgcn_readfirstlane(tid >> 6), fr0 = lane0 & 15, kq0 = lane0 >> 4;
    const int qb = wave >> 1, pb0 = 2 * (wave & 1);
    const float L2E = 1.4426950408889634f;
#define SL(i) ((LAS bf16_t*)(lds + (i) * SLOT))
#define SLF(i) ((LAS float*)(lds + (i) * SLOT))
    LAS bf16_t* const SG = SL(0); LAS bf16_t* const SS = SL(1);
    LAS float* const F0 = (LAS float*)(lds + O_F0);
    LAS float* const NP = (LAS float*)(lds + O_NP); LAS float* const BP = (LAS float*)(lds + O_BP); LAS float* const GAM = (LAS float*)(lds + O_GAM);
    const size_t rowb = (size_t)b * SEQ;
    __syncthreads();
    for (int i = tid; i < 64 * 64 / 2; i += NTHR) ((LAS unsigned*)SS)[i] = 0u;
    bf16x8 wfd[2], wfa[2], wfg[4];
    if (skip & 4096u) { wfd[0] = wfd[1] = wfa[0] = wfa[1] = wfg[0] = wfg[1] = wfg[2] = wfg[3] = (bf16x8){0, 0, 0, 0, 0, 0, 0, 0}; } else
    { const int c = h * 64 + 16 * qb + fr0;
#pragma unroll
      for (int ks = 0; ks < 2; ++ks) { u32x4 d, e;
#pragma unroll
          for (int j = 0; j < 4; ++j) { const int l = 32 * ks + 8 * kq0 + 2 * j; d[j] = pk2(-L2E * a.in[I_WDU][l * 512 + c], -L2E * a.in[I_WDU][(l + 1) * 512 + c]); e[j] = pk2(-L2E * a.in[I_WIU][l * 512 + c], -L2E * a.in[I_WIU][(l + 1) * 512 + c]); }
          wfd[ks] = __builtin_bit_cast(bf16x8, d); wfa[ks] = __builtin_bit_cast(bf16x8, e); }
#pragma unroll
      for (int ks = 0; ks < 4; ++ks) { u32x4 d;
#pragma unroll
          for (int j = 0; j < 4; ++j) { const int l = 32 * ks + 8 * kq0 + 2 * j; d[j] = pk2(a.in[I_WGU][l * 512 + c], a.in[I_WGU][(l + 1) * 512 + c]); }
          wfg[ks] = __builtin_bit_cast(bf16x8, d); } }
    const int j0 = 8 * wave;
    LAS float* const CST = (LAS float*)(lds + O_CST);
    if (tid < 320) { const int which = tid >> 6, c = tid & 63; const float* src = (which == 0) ? a.in[I_W0] : (which == 1) ? a.in[I_A0] : (which == 2) ? a.in[I_KK] : (which == 3) ? a.in[I_KA] : a.in[I_RK]; CST[tid] = src[h * 64 + c] * ((which < 2) ? -L2E : 1.0f); }
#define c_w0 (CST + 0 + j0)
#define c_a0 (CST + 64 + j0)
#define c_kk (CST + 128 + j0)
#define c_ka (CST + 192 + j0)
#define c_rk (CST + 256 + j0)
    LAS float* const GN = NP + 64; LAS float* const PS = (LAS float*)(lds + O_PS);
    if (tid >= 384) { const int c = tid - 384; GN[c] = (c < 64) ? a.in[I_GNW][h * 64 + c] : a.in[I_GNB][h * 64 + c - 64]; }
    const bool ldr = wave < 3; const int cc = ldr ? 8 * wave + (lane0 & 7) : 0, tr = lane0 >> 3;
    int col, dslot, mode = 0;
    if (cc < 8) { col = 1536 + h * 64 + cc * 8; dslot = 2; }
    else if (cc < 16) { col = 2048 + h * 64 + (cc - 8) * 8; dslot = 7; mode = 3; }
    else { col = 2560 + h * 64 + (cc - 16) * 8; dslot = 4; }
    float mu8[8];
    { const f32x4 m0 = *(const f32x4*)(a.in[I_MU] + col - 1536), m1 = *(const f32x4*)(a.in[I_MU] + col - 1536 + 4);
#pragma unroll
      for (int x = 0; x < 4; ++x) { mu8[x] = m0[x]; mu8[4 + x] = m1[x]; } }
    u32x4 raw[9], lraw[4];
    const bf16_t* gsrc = proj + (rowb + 8 * tr) * INW + col;
    const bf16_t* lsrc = lora + (size_t)b * 64 * 16384 + tid * 8;
#define RK_PREFETCH(t0_) do { _Pragma("unroll") for (int i = 0; i < 4; ++i) lraw[i] = *(const u32x4*)(lsrc + (size_t)((t0_) >> 6) * 16384 + i * 4096); \
        if (ldr) { const int tf_ = (t0_) + 8 * tr - 1; raw[0] = *(const u32x4*)(gsrc + ((long)(tf_ < 0 ? 0 : tf_) - 8 * tr) * INW); \
        _Pragma("unroll") for (int q = 1; q < 9; ++q) raw[q] = *(const u32x4*)(gsrc + ((long)(t0_) + q - 1) * INW); } } while (0)
    RK_PREFETCH(0);
    RK_BAR();
    u32x4 wout = (u32x4){0u, 0u, 0u, 0u};
#pragma unroll 1
    for (int ch = 0; ch < SEQ / 64; ++ch) {
        const int t0 = ch * 64;
#ifdef PROBE_SLEEP_RK
        __builtin_amdgcn_s_sleep(37);
#endif
        int tl_ = tid; asm volatile("" : "+v"(tl_));
        const int lane = tl_ & 63, fr = lane & 15, kq = lane >> 4;
        const bool pub_ = prog != nullptr && (ch & 3) == 1 && ch > 1 && !(skip & 0x80000000u);
        if (!(skip & 1u)) {
            int tc_ = tl_ * 16; asm volatile("" : "+v"(tc_));
            *(LAS u32x4*)(lds + 3 * SLOT + tc_) = lraw[0]; *(LAS u32x4*)(lds + 9 * SLOT + tc_) = lraw[1]; *(LAS u32x4*)(lds + 5 * SLOT + tc_) = lraw[2]; *(LAS u32x4*)(lds + 6 * SLOT + tc_) = lraw[3]; }
        if (ldr && !(skip & 1u)) {
            int tro_ = tr; asm volatile("" : "+v"(tro_));
#pragma unroll
            for (int q = 0; q < 8; ++q) { const u32x4 cu = raw[q + 1]; u32x4 pv = raw[q]; if (q == 0 && t0 + tr == 0) pv = (u32x4){0u, 0u, 0u, 0u}; float o[8];
#pragma unroll
                for (int x = 0; x < 4; ++x) { const float c0 = bflo(cu[x]), c1 = bfhi(cu[x]), p0 = bflo(pv[x]), p1 = bfhi(pv[x]); o[2 * x] = c0 + (p0 - c0) * mu8[2 * x]; o[2 * x + 1] = c1 + (p1 - c1) * mu8[2 * x + 1]; }
                u32x4 w; w.x = pk2(o[0], o[1]); w.y = pk2(o[2], o[3]); w.z = pk2(o[4], o[5]); w.w = pk2(o[6], o[7]);
                { const int row = 8 * tro_ + q; LAS bf16_t* dimg = (LAS bf16_t*)(lds + dslot * SLOT); *(LAS u32x4*)(dimg + AD(row, 8 * (cc & 7))) = w; }
                if (mode == 3) { float n2 = 0.f;
#pragma unroll
                    for (int x = 0; x < 8; ++x) { const float kr_ = o[x] * CST[128 + 8 * (cc & 7) + x]; n2 += kr_ * kr_; }
                    n2 = sum8(n2); if ((lane & 7) == 0) NP[8 * tr + q] = n2; } }
        }
        if (pub_) asm volatile("s_waitcnt vmcnt(0)" ::: "memory");
        if (!(skip & 2048u)) RK_BAR();
        if (pub_ && tid == 0) __hip_atomic_fetch_add(prog + ((ch >> 2) - 1), 1u, __ATOMIC_RELAXED, __HIP_MEMORY_SCOPE_AGENT);
        if (ch > 0 && !(skip & 0x80000000u) && !(skip & 512u)) { const bf16_t* mp_ = mix + (rowb + t0 - 64 + lane) * DM + 512 + h * 64 + j0;
            asm volatile("global_store_dwordx4 %0, %1, off sc1\n\ts_nop 1" :: "v"(mp_), "v"(wout) : "memory"); }
        if (!(skip & 2u)) { f32x4 aw[2], aa[2], ag[2]; RK_ZERO(aw); RK_ZERO(aa); RK_ZERO(ag);
          bf16x8 bw[2][2], ba[2][2], bg[4][2];
#pragma unroll
          for (int c = 0; c < 2; ++c) { const int t = 16 * (pb0 + c) + fr;
#pragma unroll
              for (int ks = 0; ks < 2; ++ks) { bw[ks][c] = *(const LAS bf16x8*)(SL(3) + AD(t, 32 * ks + 8 * kq)); ba[ks][c] = *(const LAS bf16x8*)(SL(9) + AD(t, 32 * ks + 8 * kq)); }
#pragma unroll
              for (int ks = 0; ks < 4; ++ks) bg[ks][c] = *(const LAS bf16x8*)(SL(5) + AD2(t, 32 * ks + 8 * kq)); }
          RK_LOADED();
#pragma unroll
          for (int c = 0; c < 2; ++c) {
#pragma unroll
              for (int ks = 0; ks < 2; ++ks) { aw[c] = __builtin_amdgcn_mfma_f32_16x16x32_bf16(wfd[ks], bw[ks][c], aw[c], 0, 0, 0); aa[c] = __builtin_amdgcn_mfma_f32_16x16x32_bf16(wfa[ks], ba[ks][c], aa[c], 0, 0, 0); }
#pragma unroll
              for (int ks = 0; ks < 4; ++ks) ag[c] = __builtin_amdgcn_mfma_f32_16x16x32_bf16(wfg[ks], bg[ks][c], ag[c], 0, 0, 0); }
#pragma unroll
          for (int c = 0; c < 2; ++c) { const int t = 16 * (pb0 + c) + fr, q0 = 16 * qb + 4 * kq;
              *(LAS f32x4*)(F0 + t * LDF + q0) = aw[c]; st4(SL(8), t, q0, aa[c]); st4(SG, t, q0, ag[c]); } }
        if (!(skip & 2048u)) RK_BAR();
        u32x4 xv = (u32x4){0u, 0u, 0u, 0u};
        if (!(skip & 4u)) {
          const int rj = AD(lane, j0);
          const u32x4 xk = *(const LAS u32x4*)(SL(7) + rj), xr = *(const LAS u32x4*)(SL(2) + rj), xa = *(const LAS u32x4*)(SL(8) + rj); xv = *(const LAS u32x4*)(SL(4) + rj);
          const f32x4 w0v = *(const LAS f32x4*)(F0 + lane * LDF + j0), w1v = *(const LAS f32x4*)(F0 + lane * LDF + j0 + 4);
          const float rn = __builtin_amdgcn_rsqf(fmaxf(NP[lane], 1e-24f));
          float cw0[8], ca0[8], ckk[8], cka[8], crk[8];
          { const f32x4 t0_ = *(const LAS f32x4*)(CST + j0), t1_ = *(const LAS f32x4*)(CST + j0 + 4), t2_ = *(const LAS f32x4*)(CST + 64 + j0), t3_ = *(const LAS f32x4*)(CST + 64 + j0 + 4);
            const f32x4 t4_ = *(const LAS f32x4*)(CST + 128 + j0), t5_ = *(const LAS f32x4*)(CST + 128 + j0 + 4), t6_ = *(const LAS f32x4*)(CST + 192 + j0), t7_ = *(const LAS f32x4*)(CST + 192 + j0 + 4);
            const f32x4 t8_ = *(const LAS f32x4*)(CST + 256 + j0), t9_ = *(const LAS f32x4*)(CST + 256 + j0 + 4);
#pragma unroll
            for (int x = 0; x < 4; ++x) { cw0[x] = t0_[x]; cw0[4 + x] = t1_[x]; ca0[x] = t2_[x]; ca0[4 + x] = t3_[x]; ckk[x] = t4_[x]; ckk[4 + x] = t5_[x]; cka[x] = t6_[x]; cka[4 + x] = t7_[x]; crk[x] = t8_[x]; crk[4 + x] = t9_[x]; } }
          float kap[8], bet[8], kt[8], rt[8], bg[8], kg[8], bpart = 0.f, lwv[8], cl[8], glv[8];
#pragma unroll
          for (int x = 0; x < 8; ++x) { const float wp = ((x < 4) ? w0v[x] : w1v[x - 4]) + cw0[x]; lwv[x] = (-L2E * 0.6065306597126334f) * __builtin_amdgcn_rcpf(1.0f + ex2(wp)); }
#pragma unroll
          for (int x = 0; x < 8; ++x) cl[x] = scan64(lwv[x]);
#pragma unroll
          for (int x = 0; x < 8; ++x) {
              const float kxv = (x & 1) ? bfhi(xk[x >> 1]) : bflo(xk[x >> 1]), r = (x & 1) ? bfhi(xr[x >> 1]) : bflo(xr[x >> 1]);
              const float ap = ((x & 1) ? bfhi(xa[x >> 1]) : bflo(xa[x >> 1])) + ca0[x];
              const float avv = __builtin_amdgcn_rcpf(1.0f + ex2(ap));
              const float emc = ex2(-cl[x]), epc = __builtin_amdgcn_rcpf(emc);
              const float epx = __builtin_bit_cast(float, __builtin_amdgcn_update_dpp(0x3f800000, __builtin_bit_cast(int, epc), 0x138, 0xF, 0xF, false));
              const float egl = __builtin_bit_cast(float, __builtin_amdgcn_readlane(__builtin_bit_cast(int, epc), 63)) * emc;
              const float kk = kxv * ckk[x] * rn, bq = kk * avv, km = kxv * (1.0f + (avv - 1.0f) * cka[x]);
              kap[x] = epx * kk; bet[x] = bq * emc; kt[x] = km * emc; rt[x] = r * epc; bg[x] = bq * egl; kg[x] = km * egl;
              bpart += r * km * crk[x];
              glv[x] = epc; }
          if (lane == 63) { *(LAS f32x4*)(GAM + j0) = (f32x4){glv[0], glv[1], glv[2], glv[3]}; *(LAS f32x4*)(GAM + j0 + 4) = (f32x4){glv[4], glv[5], glv[6], glv[7]}; }
          BP[wave * 64 + lane] = bpart;
          u32x4 wk, w, wb, wg;
          wk.x = pk2(kap[0], kap[1]); wk.y = pk2(kap[2], kap[3]); wk.z = pk2(kap[4], kap[5]); wk.w = pk2(kap[6], kap[7]); *(LAS u32x4*)(SL(9) + rj) = wk;
          w.x = pk2(bet[0], bet[1]); w.y = pk2(bet[2], bet[3]); w.z = pk2(bet[4], bet[5]); w.w = pk2(bet[6], bet[7]); *(LAS u32x4*)(SL(10) + rj) = w;
          w.x = pk2(kt[0], kt[1]); w.y = pk2(kt[2], kt[3]); w.z = pk2(kt[4], kt[5]); w.w = pk2(kt[6], kt[7]); *(LAS u32x4*)(SL(11) + rj) = w;
          w.x = pk2(rt[0], rt[1]); w.y = pk2(rt[2], rt[3]); w.z = pk2(rt[4], rt[5]); w.w = pk2(rt[6], rt[7]); *(LAS u32x4*)(SL(12) + rj) = w;
          wb.x = pk2(bg[0], bg[1]); wb.y = pk2(bg[2], bg[3]); wb.z = pk2(bg[4], bg[5]); wb.w = pk2(bg[6], bg[7]);
          wg.x = pk2(kg[0], kg[1]); wg.y = pk2(kg[2], kg[3]); wg.z = pk2(kg[4], kg[5]); wg.w = pk2(kg[6], kg[7]);
#pragma unroll
          for (int x = 0; x < 8; ++x) { const int tj = AD(j0 + x, lane);
              SL(5)[tj] = (bf16_t)((x & 1) ? (wk[x >> 1] >> 16) : (wk[x >> 1] & 0xffffu)); SL(6)[tj] = (bf16_t)((x & 1) ? (wb[x >> 1] >> 16) : (wb[x >> 1] & 0xffffu));
              SL(3)[tj] = (bf16_t)((x & 1) ? (wg[x >> 1] >> 16) : (wg[x >> 1] & 0xffffu)); SL(13)[tj] = (bf16_t)((x & 1) ? (xv[x >> 1] >> 16) : (xv[x >> 1] & 0xffffu)); } }
        if (!(skip & 2048u)) RK_BAR();
        if (ch + 1 < SEQ / 64 && !(skip & 1024u)) RK_PREFETCH(t0 + 64);
        const int q0 = 16 * qb + 4 * kq;
        if (!(skip & 32u)) { f32x4 a1[2], a2[2], a3[2], a4[2], a5[2]; RK_ZERO(a1); RK_ZERO(a2); RK_ZERO(a3); RK_ZERO(a4); RK_ZERO(a5);
          { Frag f1, f3; ldf(f1, SL(9), SL(10), qb, pb0, fr, kq); ldf(f3, SL(11), SL(9), qb, pb0, fr, kq); RK_LOADED();
            mmf(f1, a1);
            mmt(f1, a2);
            mmf(f3, a3); }
          { Frag f4, f5; ldf(f4, SL(12), SL(10), qb, pb0, fr, kq); ldf(f5, SL(12), SL(11), qb, pb0, fr, kq); RK_LOADED();
            mmf(f4, a4);
            mmf(f5, a5); }
#pragma unroll
          for (int c = 0; c < 2; ++c) { const int p = 16 * (pb0 + c) + fr;
#pragma unroll
              for (int x = 0; x < 4; ++x) { const int q = q0 + x; a1[c][x] = (q < p) ? a1[c][x] : 0.f; a2[c][x] = (16 * qb + fr < 16 * (pb0 + c) + 4 * kq + x) ? a2[c][x] : 0.f; a3[c][x] = (p < q) ? a3[c][x] : 0.f; a4[c][x] = (q <= p) ? a4[c][x] : 0.f; a5[c][x] = (q <= p) ? a5[c][x] : 0.f; }
              st4(SL(2), p, q0, a1[c]); st4(SL(4), 16 * qb + fr, 16 * (pb0 + c) + 4 * kq, a2[c]); st4(SL(7), p, q0, a3[c]); st4(SL(8), p, q0, a4[c]); st4(SL(14), p, q0, a5[c]); } }
        if (!(skip & 2048u)) RK_BAR();
        if (!(skip & 64u)) { f32x4 a1[2], a2[2]; RK_ZERO(a1); RK_ZERO(a2);
          { Frag f1; ldf(f1, SL(2), SL(4), qb, pb0, fr, kq); RK_LOADED();
            mmf(f1, a1);
            mmt(f1, a2); }
#pragma unroll
          for (int c = 0; c < 2; ++c) { const int p = 16 * (pb0 + c) + fr; st4(SL(9), p, q0, a1[c]); st4(SL(10), 16 * qb + fr, 16 * (pb0 + c) + 4 * kq, a2[c]); } }
        if (!(skip & 2048u)) RK_BAR();
        if (!(skip & 64u)) { f32x4 a1[2], a2[2], a3[2]; RK_ZERO(a1); RK_ZERO(a2); RK_ZERO(a3);
          f32x4 x1[2];
          { Frag f1, f3; ldf(f1, SL(9), SL(10), qb, pb0, fr, kq); ldf(f3, SL(2), SL(10), qb, pb0, fr, kq);
            f32x4 pv[2], qv[2];
#pragma unroll
            for (int c = 0; c < 2; ++c) { const int p = 16 * (pb0 + c) + fr; pv[c] = ld4(SL(2), p, q0); qv[c] = ld4(SL(9), p, q0); }
            RK_LOADED();
            mmf(f1, a1); mmt(f1, a2); mmf(f3, a3);
#pragma unroll
            for (int c = 0; c < 2; ++c) { const int p = 16 * (pb0 + c) + fr;
#pragma unroll
                for (int x = 0; x < 4; ++x) x1[c][x] = ((q0 + x == p) ? 1.0f : 0.0f) - pv[c][x] + qv[c][x] - a3[c][x]; } }
#pragma unroll
          for (int c = 0; c < 2; ++c) { const int p = 16 * (pb0 + c) + fr; st4(SL(11), p, q0, a1[c]); st4(SL(4), 16 * qb + fr, 16 * (pb0 + c) + 4 * kq, a2[c]); st4(SL(15), p, q0, x1[c]); } }
        if (!(skip & 2048u)) RK_BAR();
        if (!(skip & 64u)) { f32x4 a1[2], a2[2], a3[2]; RK_ZERO(a1); RK_ZERO(a2); RK_ZERO(a3);
          { Frag f1, f3; ldf(f1, SL(11), SL(4), qb, pb0, fr, kq); ldf(f3, SL(15), SL(4), qb, pb0, fr, kq);
#pragma unroll
            for (int c = 0; c < 2; ++c) a3[c] = ld4(SL(15), 16 * (pb0 + c) + fr, q0);
            RK_LOADED(); mmf(f1, a1); mmt(f1, a2); mmf(f3, a3); }
#pragma unroll
          for (int c = 0; c < 2; ++c) { const int p = 16 * (pb0 + c) + fr; st4(SL(2), p, q0, a1[c]); st4(SL(9), 16 * qb + fr, 16 * (pb0 + c) + 4 * kq, a2[c]); st4(SL(10), p, q0, a3[c]); } }
        if (!(skip & 2048u)) RK_BAR();
        if (!(skip & 64u)) { f32x4 a1[2], a2[2], a3[2]; RK_ZERO(a1); RK_ZERO(a2); RK_ZERO(a3);
          { Frag f1, f3; ldf(f1, SL(2), SL(9), qb, pb0, fr, kq); ldf(f3, SL(10), SL(9), qb, pb0, fr, kq);
#pragma unroll
            for (int c = 0; c < 2; ++c) a3[c] = ld4(SL(10), 16 * (pb0 + c) + fr, q0);
            RK_LOADED(); mmf(f1, a1); mmt(f1, a2); mmf(f3, a3); }
#pragma unroll
          for (int c = 0; c < 2; ++c) { const int p = 16 * (pb0 + c) + fr; st4(SL(11), p, q0, a1[c]); st4(SL(4), 16 * qb + fr, 16 * (pb0 + c) + 4 * kq, a2[c]); st4(SL(15), p, q0, a3[c]); } }
        if (!(skip & 2048u)) RK_BAR();
        if (!(skip & 64u)) { f32x4 a2[2], a3[2]; RK_ZERO(a2); RK_ZERO(a3);
          { Frag f1, f3; ldf(f1, SL(11), SL(4), qb, pb0, fr, kq); ldf(f3, SL(15), SL(4), qb, pb0, fr, kq);
#pragma unroll
            for (int c = 0; c < 2; ++c) a3[c] = ld4(SL(15), 16 * (pb0 + c) + fr, q0);
            RK_LOADED(); mmt(f1, a2); mmf(f3, a3); }
#pragma unroll
          for (int c = 0; c < 2; ++c) { const int p = 16 * (pb0 + c) + fr; st4(SL(9), 16 * qb + fr, 16 * (pb0 + c) + 4 * kq, a2[c]); st4(SL(10), p, q0, a3[c]); } }
        if (!(skip & 2048u)) RK_BAR();
        if (!(skip & 64u)) { f32x4 a3[2]; RK_ZERO(a3);
          { Frag f3; ldf(f3, SL(10), SL(9), qb, pb0, fr, kq);
#pragma unroll
            for (int c = 0; c < 2; ++c) a3[c] = ld4(SL(10), 16 * (pb0 + c) + fr, q0);
            RK_LOADED(); mmf(f3, a3); }
#pragma unroll
          for (int c = 0; c < 2; ++c) st4(SL(15), 16 * (pb0 + c) + fr, q0, a3[c]); }
        if (!(skip & 2048u)) RK_BAR();
        if (!(skip & 128u)) { f32x4 a1[2], a2[2]; RK_ZERO(a1); RK_ZERO(a2);
          { Frag f1, f2; ldf(f1, SL(5), SL(15), qb, pb0, fr, kq); ldf(f2, SL(7), SL(15), qb, pb0, fr, kq); RK_LOADED(); mmf(f1, a1); mmf(f2, a2); }
#pragma unroll
          for (int c = 0; c < 2; ++c) { const int p = 16 * (pb0 + c) + fr; st4(SL(2), p, q0, a1[c]); st4(SL(4), p, q0, a2[c]); } }
        if (!(skip & 2048u)) RK_BAR();
        if (!(skip & 128u)) { f32x4 a1[2], a2[2], a3[2], a4[2]; RK_ZERO(a1); RK_ZERO(a2); RK_ZERO(a3); RK_ZERO(a4);
          f32x4 i1[2], i2[2], i4[2];
          { Frag f1, f2, f3, f4; ldf(f1, SL(8), SL(2), qb, pb0, fr, kq); ldf(f2, SL(8), SL(4), qb, pb0, fr, kq); ldf(f3, SL(6), SL(2), qb, pb0, fr, kq); ldf(f4, SL(6), SL(4), qb, pb0, fr, kq);
#pragma unroll
            for (int c = 0; c < 2; ++c) { const int p = 16 * (pb0 + c) + fr; i1[c] = ld4(SL(12), p, q0); i2[c] = ld4(SL(14), p, q0); i4[c] = ld4(SL(3), p, q0); }
            RK_LOADED(); mmf(f1, a1); mmf(f2, a2); mmf(f3, a3); mmf(f4, a4); }
#pragma unroll
          for (int c = 0; c < 2; ++c) { const int p = 16 * (pb0 + c) + fr;
              a1[c] = i1[c] - a1[c]; a2[c] = i2[c] - a2[c]; a4[c] = i4[c] - a4[c];
#pragma unroll
              for (int x = 0; x < 4; ++x) a3[c][x] = ((q0 + x == p) ? GAM[p] : 0.0f) - a3[c][x];
              st4(SL(12), p, q0, a1[c]); st4(SL(14), p, q0, a2[c]); st4(SL(9), p, q0, a3[c]); st4(SL(3), p, q0, a4[c]); } }
        if (!(skip & 2048u)) RK_BAR();
        f32x4 sn[2]; RK_ZERO(sn);
        if (!(skip & 256u)) { f32x4 ay[2]; RK_ZERO(ay);
          { Frag f1, f2, f3, f4; ldf(f1, SL(12), SS, qb, pb0, fr, kq); ldf(f2, SL(14), SL(13), qb, pb0, fr, kq); ldf(f3, SS, SL(9), qb, pb0, fr, kq); ldf(f4, SL(13), SL(3), qb, pb0, fr, kq);
            RK_LOADED(); mmf(f1, ay); mmf(f2, ay); mmf(f3, sn); mmf(f4, sn); }
#pragma unroll
          for (int c = 0; c < 2; ++c) { const int t = 16 * (pb0 + c) + fr; *(LAS f32x4*)(F0 + t * LDF + q0) = ay[c];
              f32x2 pm; pm.x = (ay[c][0] + ay[c][1]) + (ay[c][2] + ay[c][3]); pm.y = (ay[c][0] * ay[c][0] + ay[c][1] * ay[c][1]) + (ay[c][2] * ay[c][2] + ay[c][3] * ay[c][3]);
              *(LAS f32x2*)(PS + t * LDP + 2 * (4 * qb + kq)) = pm; } }
        if (!(skip & 2048u)) RK_BAR();
#pragma unroll
        for (int c = 0; c < 2; ++c) st4(SS, 16 * (pb0 + c) + fr, q0, sn[c]);
        if (!(skip & 512u)) {
            const f32x4 y0 = *(const LAS f32x4*)(F0 + lane * LDF + j0), y1 = *(const LAS f32x4*)(F0 + lane * LDF + j0 + 4);
            float s1 = 0.f, s2 = 0.f;
#pragma unroll
            for (int k4 = 0; k4 < 8; ++k4) { const f32x4 p = *(const LAS f32x4*)(PS + lane * LDP + 4 * k4); s1 += p[0] + p[2]; s2 += p[1] + p[3]; }
            float bs = 0.f;
#pragma unroll
            for (int w = 0; w < 8; ++w) bs += BP[w * 64 + lane];
            const u32x4 gq = *(const LAS u32x4*)(SG + AD(lane, j0));
            const f32x4 gw0 = *(const LAS f32x4*)(GN + j0), gw1 = *(const LAS f32x4*)(GN + j0 + 4), gb0 = *(const LAS f32x4*)(GN + 64 + j0), gb1 = *(const LAS f32x4*)(GN + 64 + j0 + 4);
            const float mean = s1 * (1.f / 64.f), var = fmaxf(s2 * (1.f / 64.f) - mean * mean, 0.f), rstd = __builtin_amdgcn_rsqf(var + 64e-5f);
            float o[8];
#pragma unroll
            for (int x = 0; x < 8; ++x) { const float y = (x < 4) ? y0[x] : y1[x - 4], gnw = (x < 4) ? gw0[x] : gw1[x - 4], gnb = (x < 4) ? gb0[x] : gb1[x - 4];
                const float vv = (x & 1) ? bfhi(xv[x >> 1]) : bflo(xv[x >> 1]), gg = (x & 1) ? bfhi(gq[x >> 1]) : bflo(gq[x >> 1]);
                o[x] = ((y - mean) * rstd * gnw + gnb + bs * vv) * gg; }
            u32x4 w; w.x = pk2(o[0], o[1]); w.y = pk2(o[2], o[3]); w.z = pk2(o[4], o[5]); w.w = pk2(o[6], o[7]);
            wout = w; }
    }
    if (!(skip & 0x80000000u) && !(skip & 512u)) { const int ln_ = tid & 63; const bf16_t* mp_ = mix + (rowb + SEQ - 64 + ln_) * DM + 512 + h * 64 + 8 * wave;
        asm volatile("global_store_dwordx4 %0, %1, off sc1\n\ts_nop 1" :: "v"(mp_), "v"(wout) : "memory"); }
    if (prog != nullptr && !(skip & 0x80000000u)) { asm volatile("s_waitcnt vmcnt(0)" ::: "memory"); __syncthreads(); if (tid == 0) __hip_atomic_fetch_add(prog + 15, 1u, __ATOMIC_RELAXED, __HIP_MEMORY_SCOPE_AGENT); }
#undef RK_PREFETCH
#undef SL
#undef SLF
#undef c_w0
#undef c_a0
#undef c_kk
#undef c_ka
#undef c_rk
}

__device__ __forceinline__ void phase_merge(const bf16_t* opat, const float* lse, bf16_t* mix, int tid, int part, int nparts) {
    const size_t total = (size_t)MTOK * 64, stride = (size_t)nparts * NTHR;
    for (size_t idx0 = (size_t)part * NTHR + tid; idx0 < total; idx0 += 4 * stride) {
        float lv[4][3]; u32x4 av[4][3];
#pragma unroll
        for (int u = 0; u < 4; ++u) { size_t idx = idx0 + u * stride; if (idx >= total) idx = idx0;
            const size_t tok = idx >> 6; const int hd = (int)(idx & 63), h = hd >> 3, ch = hd & 7; const size_t off = tok * 512 + h * 64 + ch * 8;
#pragma unroll
            for (int g = 0; g < 3; ++g) { lv[u][g] = lse[(g * (size_t)MTOK + tok) * NH + h]; av[u][g] = *(const u32x4*)(opat + g * (size_t)MTOK * 512 + off); } }
#pragma unroll
        for (int u = 0; u < 4; ++u) { const size_t idx = idx0 + u * stride; if (idx >= total) break;
            const size_t tok = idx >> 6; const int hd = (int)(idx & 63), h = hd >> 3, ch = hd & 7;
            const float l0 = lv[u][0], l1 = lv[u][1], l2 = lv[u][2];
            const float m = fmaxf(l0, fmaxf(l1, l2)); float w0 = __expf(l0 - m), w1 = __expf(l1 - m), w2 = __expf(l2 - m); const float inv = 1.0f / (w0 + w1 + w2); w0 *= inv; w1 *= inv; w2 *= inv;
            const u32x4 a0 = av[u][0], a1 = av[u][1], a2 = av[u][2];
            u32x4 o;
#pragma unroll
            for (int q = 0; q < 4; ++q) o[q] = pk2(w0 * bflo(a0[q]) + w1 * bflo(a1[q]) + w2 * bflo(a2[q]), w0 * bfhi(a0[q]) + w1 * bfhi(a1[q]) + w2 * bfhi(a2[q]));
            *(u32x4*)(mix + tok * DM + h * 64 + ch * 8) = o; }
    }
}

constexpr int RT_WROW = 520;
constexpr int RT_WTL = 32 * RT_WROW * 2, RT_P = 2 * RT_WTL, RT_RS = RT_P + 128 * 33 * 4;
__device__ __forceinline__ void phase_route(int slab, const Args& a, LAS unsigned char* lds, int tid, const int dry = 0, const bool flow = false) {
    const int lane = tid & 63, wave = __builtin_amdgcn_readfirstlane(tid >> 6), fr = lane & 15, kq = lane >> 4;
    LAS bf16_t* WTH = (LAS bf16_t*)lds; LAS bf16_t* WTL = (LAS bf16_t*)(lds + RT_WTL);
    LAS float* P = (LAS float*)(lds + RT_P); LAS float* RS = (LAS float*)(lds + RT_RS);
    LAS int* lcnt = (LAS int*)(lds + MISC_OFF); LAS int* gbase = lcnt + 32;
    const bf16_t* h = (const bf16_t*)(a.ws + WS_H16); bf16_t* XN = (bf16_t*)(a.ws + WS_XN2);
    unsigned* cnt = (unsigned*)(a.ws + WS_CTL) + CW_CNT + slab * 32 * 16;
    unsigned* list = (unsigned*)(a.ws + WS_LIST) + (size_t)slab * NE * LCAP; unsigned* tokinfo = (unsigned*)(a.ws + WS_GLIST) + (size_t)slab * SLABT * 8;
    const float* wr = a.in[I_WR]; const float* gf = a.in[I_GFFN]; const float* br = a.in[I_BR];
    for (int it_ = 0;; ++it_) {
        int batch;
        if (flow) { unsigned* ctl = (unsigned*)(a.ws + WS_CTL); volatile LAS int* bcq = (volatile LAS int*)(lds + MISC_OFF + 512);
            __syncthreads();
            if (tid == 0) { const unsigned q = __hip_atomic_fetch_add(ctl + CW_RCLAIM, 1u, __ATOMIC_RELAXED, __HIP_MEMORY_SCOPE_AGENT);
                if (q < (unsigned)(SLABT / 128)) { const int j = (int)(q >> 5), b = (int)((q & 31u) >> 1); unsigned sp = 0;
                    while (__hip_atomic_load(ctl + CW_HDONE + 16 * b + j, __ATOMIC_RELAXED, __HIP_MEMORY_SCOPE_AGENT) < 4u) { __builtin_amdgcn_s_sleep(8); if (++sp > (1u << 22)) break; }
                    __builtin_amdgcn_fence(__ATOMIC_ACQUIRE, "agent");
                    asm volatile("s_waitcnt vmcnt(0)" ::: "memory"); }
                bcq[0] = (int)q; }
            __syncthreads();
            const int q = __builtin_amdgcn_readfirstlane(bcq[0]); if (q >= SLABT / 128) break;
            batch = 32 * ((q & 31) >> 1) + 2 * (q >> 5) + (q & 1);
        } else { batch = (int)blockIdx.x + it_ * (int)gridDim.x; if (batch >= SLABT / 128) break; }
        const int row0 = slab * SLABT + batch * 128;
        const bf16_t* hrow = h + (size_t)(row0 + wave * 16 + fr) * DM + 8 * kq;
        f32x4 acc0 = {0.f, 0.f, 0.f, 0.f}, acc1 = {0.f, 0.f, 0.f, 0.f};
        float rsl;
        { const f32x4* hp = (const f32x4*)((const float*)(a.ws + WS_LSE) + (size_t)(row0 + wave * 16 + fr) * 16); const f32x4 p0 = hp[0], p1 = hp[1], p2 = hp[2], p3 = hp[3];
          const float ss = ((p0[0] + p0[1]) + (p0[2] + p0[3])) + ((p1[0] + p1[1]) + (p1[2] + p1[3])) + ((p2[0] + p2[1]) + (p2[2] + p2[3])) + ((p3[0] + p3[1]) + (p3[2] + p3[3]));
          rsl = 1.0f / sqrtf(ss * (1.f / DM) + 1e-5f); }
        unsigned char* xo = (unsigned char*)XN + (size_t)(row0 + wave * 16 + fr) * DM + 8 * kq;
        if (tid < 32) lcnt[tid] = 0;
        u32x4 xall[32];
#pragma unroll
        for (int i = 0; i < 32; ++i) xall[i] = *(const u32x4*)(hrow + (i >> 4) * 512 + 32 * (i & 15));
        __syncthreads();
        { const u32x4* src = (const u32x4*)(a.ws + WS_WRT);
          for (int i = tid; i < RT_P / 16; i += NTHR) *(LAS u32x4*)(lds + 16 * i) = src[i]; }
        u32x4 wq[9];
        { const u32x4* src = (const u32x4*)(a.ws + WS_WRT + (size_t)RT_P);
#pragma unroll
          for (int i = 0; i < 9; ++i) { const int p = tid + i * NTHR; wq[i] = src[p < RT_P / 16 ? p : 0]; } }
        __syncthreads();
#pragma unroll
        for (int kh = 0; kh < 2; ++kh) {
            if (kh == 1) { __syncthreads();
#pragma unroll
                for (int i = 0; i < 9; ++i) { const int p = tid + i * NTHR; if (p < RT_P / 16) *(LAS u32x4*)(lds + 16 * p) = wq[i]; }
                __syncthreads(); }
#pragma unroll
            for (int ks = 0; ks < 16; ++ks) {
                const u32x4 xa = xall[kh * 16 + ks];
                { u32x2 w8; w8.x = pk4_fp8(bflo(xa.x) * rsl, bfhi(xa.x) * rsl, bflo(xa.y) * rsl, bfhi(xa.y) * rsl); w8.y = pk4_fp8(bflo(xa.z) * rsl, bfhi(xa.z) * rsl, bflo(xa.w) * rsl, bfhi(xa.w) * rsl); *(u32x2*)(xo + kh * 512 + 32 * ks) = w8; }
                const bf16x8 Ah = __builtin_bit_cast(bf16x8, xa);
                const bf16x8 Bh0 = *(const LAS bf16x8*)(WTH + fr * RT_WROW + 32 * ks + 8 * kq), Bl0 = *(const LAS bf16x8*)(WTL + fr * RT_WROW + 32 * ks + 8 * kq);
                const bf16x8 Bh1 = *(const LAS bf16x8*)(WTH + (16 + fr) * RT_WROW + 32 * ks + 8 * kq), Bl1 = *(const LAS bf16x8*)(WTL + (16 + fr) * RT_WROW + 32 * ks + 8 * kq);
                acc0 = __builtin_amdgcn_mfma_f32_16x16x32_bf16(Ah, Bh0, acc0, 0, 0, 0); acc0 = __builtin_amdgcn_mfma_f32_16x16x32_bf16(Ah, Bl0, acc0, 0, 0, 0);
                acc1 = __builtin_amdgcn_mfma_f32_16x16x32_bf16(Ah, Bh1, acc1, 0, 0, 0); acc1 = __builtin_amdgcn_mfma_f32_16x16x32_bf16(Ah, Bl1, acc1, 0, 0, 0);
            }
        }
        if (kq == 0) RS[wave * 16 + fr] = rsl;
#pragma unroll
        for (int r = 0; r < 4; ++r) { P[(wave * 16 + kq * 4 + r) * 33 + fr] = acc0[r]; P[(wave * 16 + kq * 4 + r) * 33 + 16 + fr] = acc1[r]; }
        __syncthreads();
        int te[4] = {0, 0, 0, 0}; float tg[4] = {0.f, 0.f, 0.f, 0.f}; int lp[4] = {0, 0, 0, 0};
        if (tid < 128) { const float rs = RS[tid]; float tv[4] = {-INFINITY, -INFINITY, -INFINITY, -INFINITY};
#pragma unroll 1
            for (int e = 0; e < 32; ++e) { const float v = P[tid * 33 + e] * rs + br[e];
                if (v > tv[3]) { if (v > tv[0]) { tv[3] = tv[2]; te[3] = te[2]; tv[2] = tv[1]; te[2] = te[1]; tv[1] = tv[0]; te[1] = te[0]; tv[0] = v; te[0] = e; }
                    else if (v > tv[1]) { tv[3] = tv[2]; te[3] = te[2]; tv[2] = tv[1]; te[2] = te[1]; tv[1] = v; te[1] = e; }
                    else if (v > tv[2]) { tv[3] = tv[2]; te[3] = te[2]; tv[2] = v; te[2] = e; }
                    else { tv[3] = v; te[3] = e; } } }
            const float e1 = __expf(tv[1] - tv[0]), e2 = __expf(tv[2] - tv[0]), e3 = __expf(tv[3] - tv[0]); const float inv = 1.0f / (1.0f + e1 + e2 + e3);
            tg[0] = inv; tg[1] = e1 * inv; tg[2] = e2 * inv; tg[3] = e3 * inv;
#pragma unroll
            for (int k = 0; k < 4; ++k) lp[k] = atomicAdd((int*)(lcnt + te[k]), 1); }
        __syncthreads();
        if (tid < 32) gbase[tid] = dry ? 0 : (int)atomicAdd(cnt + tid * 16, (unsigned)lcnt[tid]);
        __syncthreads();
        if (tid < 128 && !dry) {
#pragma unroll
            for (int k = 0; k < 4; ++k) { const int pos = gbase[te[k]] + lp[k]; list[(size_t)te[k] * LCAP + pos] = (unsigned)((batch * 128 + tid) * 4 + k); lp[k] = pos; }
            u32x4* ti = (u32x4*)(tokinfo + (size_t)(batch * 128 + tid) * 8);
            ti[0] = (u32x4){((unsigned)te[0] << 24) | (unsigned)lp[0], ((unsigned)te[1] << 24) | (unsigned)lp[1], ((unsigned)te[2] << 24) | (unsigned)lp[2], ((unsigned)te[3] << 24) | (unsigned)lp[3]};
            ti[1] = (u32x4){__builtin_bit_cast(unsigned, tg[0]), __builtin_bit_cast(unsigned, tg[1]), __builtin_bit_cast(unsigned, tg[2]), __builtin_bit_cast(unsigned, tg[3])}; }
#if !MOE_FP8_GU
#error "the routing phase writes xn2 as e4m3 only"
#endif
        __syncthreads();
    }
}
__device__ __forceinline__ void moe_tables(int slab, const Args& a, LAS unsigned char* lds, int nNt, int tid) {
    LAS int* tab = (LAS int*)(lds + MISC_OFF);
    const unsigned* cnt = (const unsigned*)(a.ws + WS_CTL) + CW_CNT + slab * 32 * 16;
    __syncthreads();
    if (tid < 64) {
        const int e = tid & 31;
        const int c = (int)__hip_atomic_load(cnt + e * 16, __ATOMIC_RELAXED, __HIP_MEMORY_SCOPE_AGENT);
        const int mt = (c + 255) >> 8;
        int inc = (tid < 32) ? mt : 0;
#pragma unroll
        for (int d = 1; d < 32; d <<= 1) { const int o = __shfl_up(inc, d, 64); if ((tid & 63) >= d) inc += o; }
        const int exc = inc - mt;
        if (tid < 32) { tab[e] = exc * nNt; tab[64 + e] = c; tab[128 + e] = exc * 256; if (tid == 31) tab[32] = inc * nNt; }
    }
    __syncthreads();
}
__device__ __forceinline__ void phase_final(int slab, const Args& a, LAS unsigned char* lds, int tid, const int dry = 0) {
    const int lane = tid & 63, wave = __builtin_amdgcn_readfirstlane(tid >> 6);
    moe_tables(slab, a, lds, 4, tid);
    const LAS int* tab = (const LAS int*)(lds + MISC_OFF);
    const unsigned char* EO = (const unsigned char*)(a.ws + WS_EOUT); const float* gfin = a.in[I_GFIN];
    constexpr int EB = EOUT_FP8 ? 1 : 2;
    const unsigned* tokinfo = (const unsigned*)(a.ws + WS_GLIST) + (size_t)slab * SLABT * 8;
    const int gw = blockIdx.x * NWAVES + wave, NGW = gridDim.x * NWAVES;
    f32x4 gf[4];
#pragma unroll
    for (int j = 0; j < 4; ++j) gf[j] = *((const f32x4*)gfin + lane + 64 * j);
    u32x4 inf[2], gin[2];
#pragma unroll
    for (int r = 0; r < 2; ++r) { const int rl = gw + r * NGW; const int rc = rl < SLABT ? rl : 0; inf[r] = *(const u32x4*)(tokinfo + (size_t)rc * 8); gin[r] = *(const u32x4*)(tokinfo + (size_t)rc * 8 + 4); }
    for (int rl0 = gw; rl0 < SLABT; rl0 += 2 * NGW) {
        const unsigned char* er[2][4]; float gk[2][4];
#pragma unroll
        for (int r = 0; r < 2; ++r)
#pragma unroll
            for (int k = 0; k < 4; ++k) { const unsigned w = __builtin_amdgcn_readfirstlane(inf[r][k]); er[r][k] = EO + (size_t)(tab[128 + (w >> 24)] + (int)(w & 0xffffffu)) * DM * EB; gk[r][k] = __builtin_bit_cast(float, __builtin_amdgcn_readfirstlane(gin[r][k])); }
#if EOUT_FP8
        f32x4 v[2][4]; unsigned ew[2][4][4];
#else
        f32x4 v[2][4]; u32x2 ew[2][4][4];
#endif
#pragma unroll
        for (int r = 0; r < 2; ++r) { const int rl = rl0 + r * NGW; const int rc = rl < SLABT ? rl : rl0; const bf16_t* hr = (const bf16_t*)(a.ws + WS_H16) + (size_t)(slab * SLABT + rc) * DM;
#pragma unroll
            for (int j = 0; j < 4; ++j) { const u32x2 hw = *((const u32x2*)hr + lane + 64 * j); v[r][j] = (f32x4){bflo(hw.x), bfhi(hw.x), bflo(hw.y), bfhi(hw.y)};
#pragma unroll
#if EOUT_FP8
                for (int k = 0; k < 4; ++k) ew[r][j][k] = *((const unsigned*)er[r][k] + lane + 64 * j); } }
#else
                for (int k = 0; k < 4; ++k) ew[r][j][k] = *((const u32x2*)er[r][k] + lane + 64 * j); } }
#endif
#pragma unroll
        for (int r = 0; r < 2; ++r) { const int rn = rl0 + (2 + r) * NGW; const int rc = rn < SLABT ? rn : 0; inf[r] = *(const u32x4*)(tokinfo + (size_t)rc * 8); gin[r] = *(const u32x4*)(tokinfo + (size_t)rc * 8 + 4); }
#pragma unroll
        for (int r = 0; r < 2; ++r) { const int rl = rl0 + r * NGW; float ss = 0.f;
#pragma unroll
            for (int j = 0; j < 4; ++j) {
#pragma unroll
#if EOUT_FP8
                for (int k = 0; k < 4; ++k) { const int w = (int)ew[r][j][k]; const f32x2 lo = __builtin_amdgcn_cvt_pk_f32_fp8(w, false), hi2 = __builtin_amdgcn_cvt_pk_f32_fp8(w, true);
                    v[r][j].x += gk[r][k] * lo[0]; v[r][j].y += gk[r][k] * lo[1]; v[r][j].z += gk[r][k] * hi2[0]; v[r][j].w += gk[r][k] * hi2[1]; }
#else
                for (int k = 0; k < 4; ++k) { const u32x2 w = ew[r][j][k]; v[r][j].x += gk[r][k] * bflo(w.x); v[r][j].y += gk[r][k] * bfhi(w.x); v[r][j].z += gk[r][k] * bflo(w.y); v[r][j].w += gk[r][k] * bfhi(w.y); }
#endif
                ss += (v[r][j].x * v[r][j].x + v[r][j].y * v[r][j].y) + (v[r][j].z * v[r][j].z + v[r][j].w * v[r][j].w); }
            const float rs = 1.0f / sqrtf(wave_sum(ss) * (1.f / DM) + 1e-5f);
            if (rl < SLABT) { float* hr = a.out + (size_t)(slab * SLABT + rl) * DM;
#pragma unroll
                for (int j = 0; j < 4; ++j) { const f32x4 o = v[r][j] * rs * gf[j]; if (!dry) *((f32x4*)hr + lane + 64 * j) = o; else if (o[0] == 1.2345e30f) hr[0] = 0.f; } } }
    }
}


#define XB_TMO      128
#define XB_XCNT(j)  (256  + 64 * (j))
#define XB_XSUB(j)  (1280 + 64 * (j))
#define XB_XGEN(j)  (2304 + 64 * (j))
#define XB_TOP      3328
#define XB_TOPGEN   3392
#define XCD_BAR_WORDS 3456
#define XB_SPIN_CAP (1u << 22)
__device__ __forceinline__ unsigned xb_ld(unsigned* p)              { return __hip_atomic_load(p, __ATOMIC_RELAXED, __HIP_MEMORY_SCOPE_AGENT); }
__device__ __forceinline__ unsigned xb_add(unsigned* p, unsigned v) { return __hip_atomic_fetch_add(p, v, __ATOMIC_RELAXED, __HIP_MEMORY_SCOPE_AGENT); }
__device__ __forceinline__ unsigned xb_xcc_id() { return (unsigned)__builtin_amdgcn_s_getreg((3 << 11) | 20) & 0xFu; }
#define XB_SPIN(cond, bar) do { unsigned _sp = 0; while (cond) { __builtin_amdgcn_s_sleep(1); \
    if ((++_sp & 255u) == 0u) { if (xb_ld(&(bar)[XB_TMO])) break; if (_sp > XB_SPIN_CAP) { atomicAdd(&(bar)[XB_TMO], 1u); break; } } } } while (0)
struct XcdBarrier { unsigned* bar; unsigned x; volatile LAS unsigned* st; };
__device__ __forceinline__ XcdBarrier xcd_barrier_post(unsigned* bar, volatile LAS unsigned* st) {
    XcdBarrier b; b.bar = bar; b.x = xb_xcc_id(); b.st = st;
    if (threadIdx.x == 0) (void)xb_add(&bar[XB_XCNT(b.x)], 1u);
    return b;
}
__device__ __forceinline__ void xcd_barrier_complete(unsigned* bar, unsigned x, unsigned& nloc, unsigned& nx) {
    const unsigned G = gridDim.x * gridDim.y * gridDim.z;
    unsigned sum, cnt, mine, sp = 0u;
    for (;;) {
        sum = 0u; cnt = 0u; mine = 0u;
#pragma unroll
        for (unsigned j = 0; j < 16; ++j) { const unsigned c = xb_ld(&bar[XB_XCNT(j)]); sum += c; cnt += (c > 0u) ? 1u : 0u; mine = (j == x) ? c : mine; }
        if (sum == G) break;
        __builtin_amdgcn_s_sleep(1);
        if ((++sp & 255u) == 0u) { if (xb_ld(&bar[XB_TMO])) break; if (sp > XB_SPIN_CAP) { atomicAdd(&bar[XB_TMO], 1u); break; } }
    }
    nloc = mine > 0u ? mine : 1u; nx = cnt > 0u ? cnt : 1u;
}
__device__ __forceinline__ void xcd_barrier(const XcdBarrier& b) {
    asm volatile("s_waitcnt vmcnt(0)" ::: "memory");
    __syncthreads();
    if (threadIdx.x == 0) {
        unsigned* bar = b.bar;
        __builtin_amdgcn_s_waitcnt(0);
        unsigned nloc = b.st[0], nx = b.st[1];
        if (nloc == 0u) { xcd_barrier_complete(bar, b.x, nloc, nx); b.st[0] = nloc; b.st[1] = nx; }
        const unsigned old = xb_add(&bar[XB_XSUB(b.x)], 1u);
        const unsigned gen = old / nloc;
        if (old + 1u == (gen + 1u) * nloc) {
            __builtin_amdgcn_fence(__ATOMIC_RELEASE, "agent");
            asm volatile("s_waitcnt vmcnt(0)" ::: "memory");
            const unsigned og = xb_add(&bar[XB_TOP], 1u);
            const unsigned tg = og / nx;
            if (og + 1u == (tg + 1u) * nx) xb_add(&bar[XB_TOPGEN], 1u);
            else XB_SPIN(xb_ld(&bar[XB_TOPGEN]) == tg, bar);
            __builtin_amdgcn_fence(__ATOMIC_ACQUIRE, "agent");
            xb_add(&bar[XB_XGEN(b.x)], 1u);
            asm volatile("s_waitcnt vmcnt(0)" ::: "memory");
        } else {
            XB_SPIN(xb_ld(&bar[XB_XGEN(b.x)]) == gen, bar);
            __builtin_amdgcn_fence(__ATOMIC_ACQUIRE, "agent");
            asm volatile("s_waitcnt vmcnt(0)" ::: "memory");
        }
    }
    __syncthreads();
}

__device__ __forceinline__ void sub_barrier(unsigned* ctr, unsigned n) {
    asm volatile("s_waitcnt vmcnt(0)" ::: "memory");
    __syncthreads();
    if (threadIdx.x == 0) {
        __builtin_amdgcn_fence(__ATOMIC_RELEASE, "agent");
        asm volatile("s_waitcnt vmcnt(0)" ::: "memory");
        xb_add(ctr, 1u);
        unsigned sp = 0; while (xb_ld(ctr) < n) { __builtin_amdgcn_s_sleep(2); if (++sp > (1u << 24)) break; }
        __builtin_amdgcn_fence(__ATOMIC_ACQUIRE, "agent");
        asm volatile("s_waitcnt vmcnt(0)" ::: "memory");
    }
    __syncthreads();
}

constexpr int NPHASE = 12;
struct TileSched {
    static constexpr bool PRE = false;
    int tA, tB, n;
    __device__ __forceinline__ bool next(int i, pg8::Unit& u) const { if (i >= n) return false; const int t = i ? tB : tA; u.pm = 16 * ((t & 63) >> 2) + (t >> 6); u.pn = t & 3; u.e = 0; u.cnt = 0; u.rbase = 0; return true; }
    __device__ __forceinline__ size_t b_off(const pg8::Unit& u) const { return (size_t)u.pn * 256 * DM * 2; }
    __device__ __forceinline__ unsigned a_row(const pg8::Unit& u, int r) const { return (unsigned)(u.pm * 256 + r); }
};
__device__ __forceinline__ void wo_tiles_dataflow(unsigned char* ws, const Args& a, LAS unsigned char* lds) {
    unsigned* ctl = (unsigned*)(ws + WS_CTL);
    volatile LAS int* bc = (volatile LAS int*)(lds + MISC_OFF);
    const bf16_t* MIX = (const bf16_t*)(ws + WS_MIX); const bf16_t* Wt_out = (const bf16_t*)(ws + WS_WOUT);
    constexpr int NT = MTOK / 256 * 4;
    int pending = -1;
    for (;;) {
        __syncthreads();
        if (threadIdx.x == 0) {
            int tA = pending >= 0 ? pending : (int)__hip_atomic_fetch_add(ctl + CW_TILE, 1u, __ATOMIC_RELAXED, __HIP_MEMORY_SCOPE_AGENT);
            int tB = NT, n = 0; pending = -1;
            if (tA < NT) { n = 1;
                { const int j = tA >> 6, b = (tA & 63) >> 2; unsigned sp = 0;
                  while (xb_ld(ctl + CW_PROG + b * 16 + j) < 8u || xb_ld(ctl + CW_MDONE) == 0u) { __builtin_amdgcn_s_sleep(8); if (++sp > (1u << 22)) break; } }
                tB = (int)__hip_atomic_fetch_add(ctl + CW_TILE, 1u, __ATOMIC_RELAXED, __HIP_MEMORY_SCOPE_AGENT);
                if (tB < NT) { const int j = tB >> 6, b = (tB & 63) >> 2; if (xb_ld(ctl + CW_PROG + b * 16 + j) >= 8u) n = 2; else pending = tB; }
                __builtin_amdgcn_fence(__ATOMIC_ACQUIRE, "agent");
                asm volatile("s_waitcnt vmcnt(0)" ::: "memory"); }
            bc[0] = tA; bc[1] = tB; bc[2] = n; }
        __syncthreads();
        const int tA = __builtin_amdgcn_readfirstlane(bc[0]), tB = __builtin_amdgcn_readfirstlane(bc[1]), n = __builtin_amdgcn_readfirstlane(bc[2]);
        if (n == 0) break;
        TileSched S{tA, tB, n};
        EpiResid E{a.in[I_X], (bf16_t*)(ws + WS_H16), (float*)(ws + WS_LSE)};
        pg8::gemm_phase<EpiResid, TileSched>(lds, MIX, Wt_out, DM, S, E);
        if (threadIdx.x == 0) { __hip_atomic_fetch_add(ctl + CW_HDONE + 16 * ((tA & 63) >> 2) + (tA >> 6), 1u, __ATOMIC_RELAXED, __HIP_MEMORY_SCOPE_AGENT);
            if (n == 2) __hip_atomic_fetch_add(ctl + CW_HDONE + 16 * ((tB & 63) >> 2) + (tB >> 6), 1u, __ATOMIC_RELAXED, __HIP_MEMORY_SCOPE_AGENT); }
    }
}
__global__ void __launch_bounds__(NTHR, 2) mega_fwd(Args args) {
    extern __shared__ __attribute__((aligned(16))) unsigned char lds_raw[];
    LAS unsigned char* lds = (LAS unsigned char*)lds_raw;
    const int tid0 = threadIdx.x;
#define OT() ({ int t_ = tid0; asm volatile("" : "+v"(t_)); t_; })
    const int G = gridDim.x, bx = blockIdx.x;
    const int vcu = (G % 8 == 0) ? (bx % 8) * (G / 8) + bx / 8 : bx;
#define KA() args
    unsigned char* ws = args.ws;
    bf16_t* Wt_in = (bf16_t*)(ws + WS_WIN); bf16_t* Wt_out = (bf16_t*)(ws + WS_WOUT); bf16_t* Wt_gu = (bf16_t*)(ws + WS_WGU); bf16_t* Wt_dn = (bf16_t*)(ws + WS_WDN);
    bf16_t* XN = (bf16_t*)(ws + WS_XN); bf16_t* PROJ = (bf16_t*)(ws + WS_PROJ); bf16_t* MIX = (bf16_t*)(ws + WS_MIX);
    bf16_t* ACT = (bf16_t*)(ws + WS_ACT); bf16_t* EOUT = (bf16_t*)(ws + WS_EOUT);
    float* LSE = (float*)(ws + WS_LSE); bf16_t* OPAT = (bf16_t*)KA().out;
    const int lo = KA().ph_lo, hi = KA().ph_hi;
#if MK_MULTI
#define GRID_SYNC() do { } while (0)
#elif USE_CG_SYNC
    cg::grid_group grid = cg::this_grid();
#define GRID_SYNC() grid.sync()
#else
    { volatile LAS unsigned* stw = (volatile LAS unsigned*)(lds + XBST_OFF); if (tid0 < 2) stw[tid0] = 0u; }
    __syncthreads();
    const XcdBarrier xbar = xcd_barrier_post((unsigned*)(ws + WS_CTL) + CW_BAR, (volatile LAS unsigned*)(lds + XBST_OFF));
#define GRID_SYNC() xcd_barrier(xbar)
#endif
#ifndef PHM
#define PHM 0xFFFF
#endif
#define IN(k) (((PHM >> (k)) & 1) && lo <= (k) && (k) < hi)
#define SEAM(k) do { if (IN(k) && IN((k) + 1)) { GRID_SYNC(); } } while (0)
#ifndef PROBE_DUP
#define PROBE_DUP -1
#endif
#ifndef PROBE_SUB
#define PROBE_SUB 0
#endif
#ifndef PROBE_MASK
#define PROBE_MASK 0
#endif
#ifndef PROBE_AMASK
#define PROBE_AMASK 0
#endif
#ifdef PROBE_WET
#define PROBE_WET_FLAG 0u
#else
#define PROBE_WET_FLAG 0x80000000u
#endif
#define REPS(k) for (int rep_ = 0; rep_ < ((PROBE_DUP == (k)) ? 2 : 1); ++rep_, (rep_ < ((PROBE_DUP == (k)) ? 2 : 1) ? (GRID_SYNC(), 0) : 0))

    if (IN(0)) REPS(0) { const int t_ = OT(); phase_prologue(KA(), lds, __builtin_amdgcn_readfirstlane(t_ >> 6), t_ & 63); }
    SEAM(0);
#ifndef STAG1
#define STAG1 0
#endif
    if (IN(1)) REPS(1) {
#ifdef STAG2
        for (int sl_ = 0; sl_ < STAG2 * ((bx >> 3) & 1); ++sl_) __builtin_amdgcn_s_sleep(127);
#endif
        for (int sl_ = 0; sl_ < STAG1 * (bx & 7); ++sl_) __builtin_amdgcn_s_sleep(127);
        DenseSched S; S.o.init(MTOK, INW, G, bx); EpiProj E{PROJ};
#if ATTN_QKV8
        E.O8 = ws + WS_QKV8;
#endif
#ifdef PROBE_ALIAS
        if (rep_ == 1) { E.O = (bf16_t*)(ws + WS_H16); E.alias = 1; }
#endif
        pg8::gemm_phase<EpiProj, DenseSched>(lds, XN, Wt_in, DM, S, E); }
    SEAM(1);
    if (IN(2)) { phase_lora_pre(KA(), PROJ, (bf16_t*)(ws + WS_LORA), OT()); GRID_SYNC(); }
    if (IN(2)) REPS(2) {
        const int nR = (G >= 256) ? 128 : G / 2;
#ifndef NO_RWKV
        if (bx < nR && !(rep_ == 1 && (PROBE_SUB & 2))) { for (int hd = bx; hd < NB * NH; hd += nR) RWKV_FN(hd >> 3, hd & 7, KA(), PROJ, MIX, lds, OT(), (rep_ == 1) ? (PROBE_WET_FLAG | (unsigned)PROBE_MASK) : 0u, (const bf16_t*)(ws + WS_LORA), (WO_FUSED && !MK_MULTI) ? (unsigned*)(ws + WS_CTL) + CW_PROG + (hd >> 3) * 16 : nullptr);
            if (rep_ == 0) { __syncthreads(); const int t_ = OT(); expert_weight_items(KA(), lds, __builtin_amdgcn_readfirstlane(t_ >> 6), t_ & 63, 0, 1); } }
#endif
#ifndef NO_ATTN
        if (bx >= nR && !(rep_ == 1 && (PROBE_SUB & 1))) { attn_loop(bx - nR, G - nR, 3 * 2048, ws + WS_QKV8, OPAT, LSE, lds, OT(), (rep_ == 1) ? (0x80000000u | (unsigned)PROBE_AMASK) : 0u);
            if (rep_ == 0) {
#if !MK_MULTI
                sub_barrier((unsigned*)(ws + WS_CTL) + CW_SUB, (unsigned)(G - nR));
                for (int r2_ = 0; r2_ < ((PROBE_DUP == 9) ? 3 : 1); ++r2_)
                phase_merge(OPAT, LSE, MIX, OT(), bx - nR, G - nR);
#if WO_FUSED
                sub_barrier((unsigned*)(ws + WS_CTL) + CW_SUB2, (unsigned)(G - nR));
                if (tid0 == 0) __hip_atomic_store((unsigned*)(ws + WS_CTL) + CW_MDONE, 1u, __ATOMIC_RELAXED, __HIP_MEMORY_SCOPE_AGENT);
#endif
#endif
                { const int t_ = OT(); expert_weight_items(KA(), lds, __builtin_amdgcn_readfirstlane(t_ >> 6), t_ & 63, bx - nR, G - nR); } } }
#endif
#if WO_FUSED && !MK_MULTI
        if (rep_ == 0) { wo_tiles_dataflow(ws, KA(), lds);
            if (PROBE_DUP != 5) phase_route(0, KA(), lds, OT(), 0, true); }
#endif
    }
    SEAM(2);
#if MK_MULTI
    if (IN(3)) REPS(3) { phase_merge(OPAT, LSE, MIX, OT(), bx, G); }
#endif
#if !(WO_FUSED && !MK_MULTI)
    if (IN(4)) REPS(4) { DenseSched S; S.o.init(MTOK, DM, G, bx); const Args& A_ = KA(); EpiResid E{A_.in[I_X], (bf16_t*)(ws + WS_H16), (float*)(ws + WS_LSE)}; pg8::gemm_phase<EpiResid, DenseSched>(lds, MIX, Wt_out, DM, S, E); }
    SEAM(4);
#endif
#pragma unroll 1
    for (int slab = 0; slab < NSLAB; ++slab) {
        const int p0 = 5 + 3 * slab;
        unsigned* list = (unsigned*)(ws + WS_LIST) + (size_t)slab * NE * LCAP; float* glist = (float*)(ws + WS_GLIST) + (size_t)slab * NE * LCAP;
#if WO_FUSED && !MK_MULTI
        if (slab == 0 && PROBE_DUP == 5) { if (IN(5)) { phase_route(0, KA(), lds, OT(), 1); GRID_SYNC(); phase_route(0, KA(), lds, OT()); } SEAM(5); }
#else
        if (slab == 0) { if (IN(5)) { if (PROBE_DUP == 5) { phase_route(0, KA(), lds, OT(), 1); GRID_SYNC(); } phase_route(0, KA(), lds, OT()); } SEAM(5); }
#endif
        if (IN(p0 + 1)) REPS(6) { const Args& A_ = KA(); moe_tables(slab, A_, lds, 8, OT());
            constexpr int EB = MOE_FP8_GU ? 1 : 2;
            MoeSched S{(const LAS int*)(lds + MISC_OFF), 8, G, vcu, list, (unsigned)(slab * SLABT), (rep_ == 1 && (PROBE_MASK & 2)) ? 0 : 1, (size_t)2 * DFF * DM * EB, (size_t)256 * DM * EB};
            EpiSwiglu E{ACT, A_.in[I_BGUP], (rep_ == 1) ? (PROBE_MASK | 4) : 0, lds + BIAS_OFF}; pg8::gemm_phase<EpiSwiglu, MoeSched, MOE_FP8_GU != 0>(lds, (const bf16_t*)(ws + WS_XN2), Wt_gu, DM * EB / 2, S, E); }
        SEAM(p0 + 1);
        if (IN(p0 + 2)) REPS(7) { const Args& A_ = KA(); moe_tables(slab, A_, lds, 4, OT());
            constexpr int EB = MOE_FP8_DN ? 1 : 2;
            MoeSched S{(const LAS int*)(lds + MISC_OFF), 4, G, vcu, list, 0u, 0, (size_t)DM * DFF * EB, (size_t)256 * DFF * EB};
            EpiDown E{EOUT, A_.in[I_BDN], (rep_ == 1) ? PROBE_MASK : 0, lds + BIAS_OFF}; pg8::gemm_phase<EpiDown, MoeSched, MOE_FP8_DN != 0>(lds, ACT, Wt_dn, DFF * EB / 2, S, E); }
        SEAM(p0 + 2);
        if (IN(p0 + 3)) { const int t_ = OT(); if (PROBE_DUP == 8) { phase_final(slab, KA(), lds, t_, 1); GRID_SYNC(); } phase_final(slab, KA(), lds, t_); if (slab + 1 < NSLAB) { __syncthreads(); phase_route(slab + 1, KA(), lds, OT()); } }
        if (slab + 1 < NSLAB) SEAM(p0 + 3);
    }
#undef IN
#undef REPS
#undef SEAM
#undef GRID_SYNC
#undef KA
#undef OT
}

extern "C" void kernel_launch(void* const* d_in, const int* in_sizes, int n_in, void* d_out, int out_size, void* d_ws, size_t ws_size, hipStream_t stream) {
    static int grid = 0;
    if (grid == 0) {
        if (n_in != 23 || in_sizes[0] != MTOK * DM || out_size != MTOK * DM || ws_size < WS_NEED) { fprintf(stderr, "kernel_launch: unexpected shapes (n_in %d, in0 %d, out %d, ws %zu)\n", n_in, n_in > 0 ? in_sizes[0] : -1, out_size, ws_size); grid = -1; return; }
        int dev = 0, cus = 0, per_cu = 0;
        if (hipGetDevice(&dev) != hipSuccess || hipDeviceGetAttribute(&cus, hipDeviceAttributeMultiprocessorCount, dev) != hipSuccess) { grid = -1; return; }
        if (hipFuncSetAttribute((const void*)mega_fwd, hipFuncAttributeMaxDynamicSharedMemorySize, LDS_BYTES) != hipSuccess) { fprintf(stderr, "kernel_launch: hipFuncSetAttribute failed\n"); grid = -1; return; }
        if (hipOccupancyMaxActiveBlocksPerMultiprocessor(&per_cu, (const void*)mega_fwd, NTHR, LDS_BYTES) != hipSuccess || per_cu < 1) { fprintf(stderr, "kernel_launch: occupancy query says %d\n", per_cu); per_cu = 1; }
        (void)hipGetLastError();
        grid = cus;
    }
    if (grid < 0) return;
    (void)hipMemsetAsync((char*)d_ws + WS_CTL, 0, CTL_BYTES, stream);
    Args a{};
    for (int i = 0; i < 23; ++i) a.in[i] = (const float*)d_in[i];
    a.out = (float*)d_out; a.ws = (unsigned char*)d_ws;
#if MK_MULTI
    for (int p = 0; p < NPHASE; ++p) { a.ph_lo = p; a.ph_hi = p + 1; hipLaunchKernelGGL(mega_fwd, dim3(grid), dim3(NTHR), LDS_BYTES, stream, a); }
#else
    a.ph_lo = 0; a.ph_hi = NPHASE;
    void* kargs[] = {&a};
    hipError_t e = hipLaunchCooperativeKernel((const void*)mega_fwd, dim3(grid), dim3(NTHR), kargs, LDS_BYTES, stream);
    if (e != hipSuccess) fprintf(stderr, "kernel_launch: cooperative launch failed: %s (grid %d)\n", hipGetErrorString(e), grid);
#endif
}
```
